# Optimizing an MI355X kernel written in HIP

```python
import math
import jax, jax.numpy as jnp
from jax import lax
import numpy as np

D_MODEL = 1024
BATCH = 1
SEQ = 16384
DEPTH = 4

HEAD_DIM = 64
NA_HEADS = 8
DIFF_HEADS = 4
GQA_Q_HEADS = 8
GQA_KV_HEADS = 2
BRANCH_WIDTH = 512
N_BRANCHES = 3
D_FF = 2816
GRID_W = 64
NA_WIN_ROWS = 8
NA_WIN_COLS = 16
WINDOW = 128
BLOCK = 128
T5_BUCKETS = 32
T5_MAX_DIST = 128
T5_HEADS = DIFF_HEADS + GQA_Q_HEADS
NEG_INF = -1e30
EPS = 1e-6

PROJ_SPLITS = (
    NA_HEADS * HEAD_DIM, NA_HEADS * HEAD_DIM, NA_HEADS * HEAD_DIM,
    DIFF_HEADS * 2 * HEAD_DIM, DIFF_HEADS * 2 * HEAD_DIM, DIFF_HEADS * 2 * HEAD_DIM,
    GQA_Q_HEADS * HEAD_DIM, GQA_KV_HEADS * HEAD_DIM, GQA_KV_HEADS * HEAD_DIM,
)
W_IN_COLS = sum(PROJ_SPLITS)
PROJ_OFFSETS = tuple(sum(PROJ_SPLITS[:i + 1]) for i in range(len(PROJ_SPLITS) - 1))

kernel_name = "hybrid_parallel_gated_encoder"


def rms_norm(x, g):
    xf = x.astype(jnp.float32)
    y = xf * lax.rsqrt(jnp.mean(xf * xf, axis=-1, keepdims=True) + EPS)
    return (y * g.astype(jnp.float32)).astype(x.dtype)


def swiglu(h, w_gate, w_up, w_down):
    return (jax.nn.silu(h @ w_gate) * (h @ w_up)) @ w_down


def t5_bucket(rel):
    half = T5_BUCKETS // 2
    max_exact = half // 2
    ret = (rel > 0).astype(jnp.int32) * half
    n = jnp.abs(rel)
    nf = jnp.maximum(n, 1).astype(jnp.float32)
    large = max_exact + (jnp.log(nf / max_exact) / math.log(T5_MAX_DIST / max_exact)
                         * (half - max_exact)).astype(jnp.int32)
    large = jnp.minimum(large, half - 1)
    return ret + jnp.where(n < max_exact, n, large)


def neighbourhood_attention(q, k, v, rpb):
    B, S, H, D = q.shape
    rows = S // GRID_W
    wr = min(NA_WIN_ROWS, rows)
    qg = q.reshape(B, rows, GRID_W, H, D)
    kg = k.reshape(B, rows, GRID_W, H, D)
    vg = v.reshape(B, rows, GRID_W, H, D)
    r = jnp.arange(rows)
    rs = jnp.clip(r - wr // 2, 0, rows - wr)
    row_idx = rs[:, None] + jnp.arange(wr)[None, :]
    kn = kg[:, row_idx]
    vn = vg[:, row_idx]
    s = jnp.einsum('brqhd,brikhd->bhrqik', qg, kn) * (D ** -0.5)
    c = jnp.arange(GRID_W)
    cs = jnp.clip(c - NA_WIN_COLS // 2, 0, GRID_W - NA_WIN_COLS)
    col_ok = (c[None, :] >= cs[:, None]) & (c[None, :] < cs[:, None] + NA_WIN_COLS)
    dr = row_idx - r[:, None] + (NA_WIN_ROWS - 1)
    dc = jnp.clip(c[None, :] - c[:, None] + (NA_WIN_COLS - 1), 0, 2 * NA_WIN_COLS - 2)
    bias = rpb[:, dr[:, None, :, None], dc[None, :, None, :]]
    logits = s.astype(jnp.float32) + bias.astype(jnp.float32)[None]
    logits = jnp.where(col_ok[:, None, :], logits, NEG_INF)
    p = jax.nn.softmax(logits.reshape(B, H, rows, GRID_W, wr * GRID_W), axis=-1)
    p = p.reshape(logits.shape).astype(v.dtype)
    o = jnp.einsum('bhrqik,brikhd->brqhd', p, vn)
    return o.reshape(B, S, H * D)


def diff_attention(q, k, v, lam, lam_init, subln_g, bias_table):
    B, S, H, _, D = q.shape
    nb = S // BLOCK
    qb = jnp.moveaxis(q.reshape(B, nb, BLOCK, H, 2, D), 1, 0)
    starts = jnp.arange(nb, dtype=jnp.int32) * BLOCK
    kpos = jnp.arange(S, dtype=jnp.int32)
    qoff = jnp.arange(BLOCK, dtype=jnp.int32)

    def block(args):
        qblk, start = args
        s = jnp.einsum('bqhcd,bkhcd->bhcqk', qblk, k) * (D ** -0.5)
        rel = kpos[None, :] - (start + qoff)[:, None]
        bias = jnp.transpose(bias_table[t5_bucket(rel)], (2, 0, 1))
        p = jax.nn.softmax(s.astype(jnp.float32) + bias.astype(jnp.float32)[None, :, None], axis=-1)
        a = p[:, :, 0] - lam * p[:, :, 1]
        return jnp.einsum('bhqk,bkhe->bqhe', a.astype(v.dtype), v)

    o = lax.map(block, (qb, starts))
    o = jnp.moveaxis(o, 0, 1).reshape(B, S, H, 2 * D)
    o = rms_norm(o, subln_g) * (1.0 - lam_init)
    return o.reshape(B, S, H * 2 * D)


def window_gqa(q, k, v, sink, bias_table):
    B, S, Hq, D = q.shape
    Hkv = k.shape[2]
    G = Hq // Hkv
    nb = S // BLOCK
    pad = ((0, 0), (BLOCK, BLOCK), (0, 0), (0, 0))
    kp = jnp.pad(k, pad).reshape(B, nb + 2, BLOCK, Hkv, D)
    vp = jnp.pad(v, pad).reshape(B, nb + 2, BLOCK, Hkv, D)
    kb = jnp.concatenate([kp[:, :-2], kp[:, 1:-1], kp[:, 2:]], axis=2)
    vb = jnp.concatenate([vp[:, :-2], vp[:, 1:-1], vp[:, 2:]], axis=2)
    qb = q.reshape(B, nb, BLOCK, Hkv, G, D)
    s = jnp.einsum('bnqhgd,bnkhd->bnhgqk', qb, kb) * (D ** -0.5)
    qi = jnp.arange(BLOCK, dtype=jnp.int32)
    kk = jnp.arange(3 * BLOCK, dtype=jnp.int32)
    rel = kk[None, :] - BLOCK - qi[:, None]
    bias = jnp.transpose(bias_table[t5_bucket(rel)], (2, 0, 1)).reshape(Hkv, G, BLOCK, 3 * BLOCK)
    kpos = jnp.arange(nb, dtype=jnp.int32)[:, None] * BLOCK - BLOCK + kk[None, :]
    ok = (jnp.abs(rel) <= WINDOW)[None] & ((kpos >= 0) & (kpos < S))[:, None, :]
    logits = jnp.where(ok[None, :, None, None], s.astype(jnp.float32) + bias.astype(jnp.float32)[None, None], NEG_INF)
    sink_l = jnp.broadcast_to(sink.astype(jnp.float32).reshape(Hkv, G, 1, 1), logits.shape[:-1] + (1,))
    p = jax.nn.softmax(jnp.concatenate([logits, sink_l], axis=-1), axis=-1)[..., :-1]
    o = jnp.einsum('bnhgqk,bnkhd->bnqhgd', p.astype(v.dtype), vb)
    return o.reshape(B, S, Hq * D)


def setup_inputs(seed: int = 0) -> dict:
    key = jax.random.key(seed)
    ks = jax.random.split(key, 16)

    def nrm(k, shape, scale):
        return jax.random.normal(k, shape, jnp.float32) * scale

    return {
        "x": nrm(ks[0], (BATCH, SEQ, D_MODEL), 1.0),
        "w_in": nrm(ks[1], (DEPTH, D_MODEL, W_IN_COLS), D_MODEL ** -0.5),
        "w_branch": nrm(ks[2], (DEPTH, N_BRANCHES, BRANCH_WIDTH, D_MODEL), BRANCH_WIDTH ** -0.5),
        "w_gate": nrm(ks[3], (DEPTH, D_MODEL, N_BRANCHES * D_MODEL), D_MODEL ** -0.5),
        "b_gate": nrm(ks[4], (DEPTH, N_BRANCHES * D_MODEL), 0.02),
        "w_o": nrm(ks[5], (DEPTH, D_MODEL, D_MODEL), D_MODEL ** -0.5),
        "norm_g": 1.0 + nrm(ks[6], (DEPTH, 3, D_MODEL), 0.02),
        "final_g": 1.0 + nrm(ks[7], (D_MODEL,), 0.02),
        "ffn_w_gate": nrm(ks[8], (DEPTH, 2, D_MODEL, D_FF), D_MODEL ** -0.5),
        "ffn_w_up": nrm(ks[9], (DEPTH, 2, D_MODEL, D_FF), D_MODEL ** -0.5),
        "ffn_w_down": nrm(ks[10], (DEPTH, 2, D_FF, D_MODEL), D_FF ** -0.5),
        "na_rpb": nrm(ks[11], (DEPTH, NA_HEADS, 2 * NA_WIN_ROWS - 1, 2 * NA_WIN_COLS - 1), 0.1),
        "diff_lambda": nrm(ks[12], (DEPTH, 4, HEAD_DIM), 0.1),
        "diff_subln_g": 1.0 + nrm(ks[13], (DEPTH, 2 * HEAD_DIM), 0.02),
        "gqa_sink": nrm(ks[14], (DEPTH, GQA_Q_HEADS), 0.5),
        "rel_bias_table": nrm(ks[15], (T5_BUCKETS, T5_HEADS), 0.1),
    }


def reference(x, w_in, w_branch, w_gate, b_gate, w_o, norm_g, final_g,
              ffn_w_gate, ffn_w_up, ffn_w_down, na_rpb, diff_lambda, diff_subln_g,
              gqa_sink, rel_bias_table):
    B, S, _ = x.shape
    for l in range(DEPTH):
        h = rms_norm(x, norm_g[l, 0])
        x = x + 0.5 * swiglu(h, ffn_w_gate[l, 0], ffn_w_up[l, 0], ffn_w_down[l, 0])

        h = rms_norm(x, norm_g[l, 1])
        proj = h @ w_in[l]
        qa, ka, va, qd, kd, vd, qc, kc, vc = jnp.split(proj, PROJ_OFFSETS, axis=-1)

        ya = neighbourhood_attention(qa.reshape(B, S, NA_HEADS, HEAD_DIM),
                                     ka.reshape(B, S, NA_HEADS, HEAD_DIM),
                                     va.reshape(B, S, NA_HEADS, HEAD_DIM), na_rpb[l])

        lam_init = 0.8 - 0.6 * math.exp(-0.3 * l)
        lq = diff_lambda[l].astype(jnp.float32)
        lam = jnp.exp(jnp.sum(lq[0] * lq[1])) - jnp.exp(jnp.sum(lq[2] * lq[3])) + lam_init
        yb = diff_attention(qd.reshape(B, S, DIFF_HEADS, 2, HEAD_DIM),
                            kd.reshape(B, S, DIFF_HEADS, 2, HEAD_DIM),
                            vd.reshape(B, S, DIFF_HEADS, 2 * HEAD_DIM),
                            lam, lam_init, diff_subln_g[l], rel_bias_table[:, :DIFF_HEADS])

        yc = window_gqa(qc.reshape(B, S, GQA_Q_HEADS, HEAD_DIM),
                        kc.reshape(B, S, GQA_KV_HEADS, HEAD_DIM),
                        vc.reshape(B, S, GQA_KV_HEADS, HEAD_DIM),
                        gqa_sink[l], rel_bias_table[:, DIFF_HEADS:])

        g = jax.nn.sigmoid(h @ w_gate[l] + b_gate[l]).reshape(B, S, N_BRANCHES, D_MODEL)
        merged = (g[:, :, 0] * (ya @ w_branch[l, 0])
                  + g[:, :, 1] * (yb @ w_branch[l, 1])
                  + g[:, :, 2] * (yc @ w_branch[l, 2]))
        x = x + merged @ w_o[l]

        h = rms_norm(x, norm_g[l, 2])
        x = x + 0.5 * swiglu(h, ffn_w_gate[l, 1], ffn_w_up[l, 1], ffn_w_down[l, 1])
    return rms_norm(x, final_g)
```

```cpp
#include <hip/hip_runtime.h>
#include <hip/hip_cooperative_groups.h>
#include <cstdio>
#include <cstdint>
namespace cg = cooperative_groups;
namespace pg8 {
#define PG8_LAS __attribute__((address_space(3)))
typedef unsigned short bf16_t;
typedef short bf16x8 __attribute__((ext_vector_type(8)));
typedef float f32x4 __attribute__((ext_vector_type(4)));
typedef unsigned u32x4 __attribute__((ext_vector_type(4)));
constexpr int BM = 256, BK = 64, HALF = 128, HTB = HALF * BK * 2  , STAGE_BYTES = 8 * HTB, NXCD = 8, WGM = 8;

__host__ __device__ __forceinline__ int lds_byte(int r, int c) { const int st = (r >> 4) * 2 + (c >> 5), rr = r & 15, cc = c & 31, ob = rr * 64 + cc * 2; return st * 1024 + (ob ^ (((ob >> 9) & 1) << 5)); }
__host__ __device__ __forceinline__ void stage_rc(int b, int& R, int& C) { const int st = b / 1024, sb = b % 1024, swz = sb ^ (((sb >> 9) & 1) << 5); R = (st >> 1) * 16 + swz / 64; C = (st & 1) * 32 + (swz % 64) / 2; }
__host__ __device__ __forceinline__ int perm32(int rho) { const int n = rho >> 4, i = rho & 15; return 8 * (i >> 2) + 4 * n + (i & 3); }

struct Unit { int pm, pn; };
struct Gemm { const bf16_t* A; const bf16_t* Bt; int M, N, K; };

struct StaticOrder {
    int nM, nN, nwg, G, c;
    __host__ __device__ void init(int M, int N, int G_, int c_) { nM = M / BM; nN = N / BM; nwg = nM * nN; G = G_; c = c_; }
    __host__ __device__ bool next(int i, Unit& u) const {
        const long L = (long)i * G + c; if (L >= nwg) return false;
        int wgid = (int)L; { const int q = nwg / NXCD, r = nwg % NXCD, xcd = wgid % NXCD, off = wgid / NXCD; wgid = (xcd < r ? xcd * (q + 1) : r * (q + 1) + (xcd - r) * q) + off; }
        const int nig = WGM * nN, gid = wgid / nig, fm = gid * WGM, gsz = (nM - fm) < WGM ? (nM - fm) : WGM;
        u.pm = fm + ((wgid % nig) % gsz); u.pn = (wgid % nig) / gsz; return true;
    }
    __device__ __forceinline__ void a_ready(const Unit&) const {}
    __device__ __forceinline__ void done(const Unit&) const {}
};

typedef float f32x2c __attribute__((ext_vector_type(2))); typedef __bf16 bf16x2c __attribute__((ext_vector_type(2)));
__device__ __forceinline__ unsigned cvt_pk_bf16(float lo, float hi) { f32x2c v = {lo, hi}; bf16x2c b = __builtin_convertvector(v, bf16x2c); return __builtin_bit_cast(unsigned, b); }
__device__ __forceinline__ int pg8_opaque_tid() { int t = threadIdx.x; asm volatile("" : "+v"(t)); return t; }
template <class Epi, class Sched, bool ALIGN_EPI = false, bool SP2 = false>
__device__ __forceinline__ void gemm_phase(PG8_LAS unsigned char* lds, const Gemm g, const Sched& S, const Epi& E) {
    const int tid = pg8_opaque_tid(), wid = __builtin_amdgcn_readfirstlane(tid >> 6), lane = tid & 63, wr = wid >> 2, wc = wid & 3, fr = lane & 15, fq = lane >> 4;
    const int K = g.K, nt = K / BK;
    unsigned voffA[2], voffB[2];
#pragma unroll
    for (int i = 0; i < 2; ++i) { int R, C; stage_rc(tid * 16 + i * 8192, R, C); const int Rb = Epi::PERM ? ((R & ~31) + perm32(R & 31)) : R;
        voffA[i] = (unsigned)(R * K + C) * 2u; voffB[i] = (unsigned)(Rb * K + C) * 2u; }
    const size_t kstep = (size_t)(BK * 2);
    const size_t hstep = (size_t)HALF * K * 2;
    const size_t tstep = 2 * hstep;
    const unsigned ldsw = (unsigned)wid * 1024u;
    const int aoff = lds_byte(wr * 64 + fr, fq * 8), boff = lds_byte(wc * 32 + fr, fq * 8);
#define PG8_SA(b, h) (((b) * 2 + (h)) * HTB)
#define PG8_SB(b, h) ((4 + (b) * 2 + (h)) * HTB)
#define PG8_STAGE(bufoff, gbase, voff) do { _Pragma("unroll") for (int _i = 0; _i < 2; ++_i) \
        __builtin_amdgcn_global_load_lds((const unsigned*)((const char*)(gbase) + (voff)[_i]), (PG8_LAS unsigned*)(lds + (bufoff) + ldsw + _i * 8192), 16, 0, 0); } while (0)
#define PG8_LDA(dst, b, h) do { _Pragma("unroll") for (int m = 0; m < 4; ++m) _Pragma("unroll") for (int k = 0; k < 2; ++k) dst[m][k] = *(const PG8_LAS bf16x8*)(lds + PG8_SA(b, h) + aoff + m * 2048 + k * 1024); } while (0)
#define PG8_LDB(dst, b, h) do { _Pragma("unroll") for (int n = 0; n < 2; ++n) _Pragma("unroll") for (int k = 0; k < 2; ++k) dst[n][k] = *(const PG8_LAS bf16x8*)(lds + PG8_SB(b, h) + boff + n * 2048 + k * 1024); } while (0)
#define PG8_MMA(ai, bj, At, Bt) do { __builtin_amdgcn_s_setprio(1); _Pragma("unroll") for (int m = 0; m < 4; ++m) _Pragma("unroll") for (int n = 0; n < 2; ++n) _Pragma("unroll") for (int k = 0; k < 2; ++k) \
        acc[ai][bj][m][n] = __builtin_amdgcn_mfma_f32_16x16x32_bf16(Bt[n][k], At[m][k], acc[ai][bj][m][n], 0, 0, 0); __builtin_amdgcn_s_setprio(0); } while (0)
#define PG8_WAIT_V(n) asm volatile("s_waitcnt vmcnt(" #n ")" ::: "memory")
#define PG8_WAIT_L(n) asm volatile("s_waitcnt lgkmcnt(" #n ")" ::: "memory")
#define PG8_BAR __builtin_amdgcn_s_barrier()
#define PG8_SCHED __builtin_amdgcn_sched_barrier(0)
    Unit cur, nxt; int ui = 0;
    if (!S.next(0, cur)) return;
    f32x4 acc[2][2][4][2];
#pragma unroll
    for (int a = 0; a < 2; ++a)
#pragma unroll
        for (int b = 0; b < 2; ++b)
#pragma unroll
            for (int m = 0; m < 4; ++m)
#pragma unroll
                for (int n = 0; n < 2; ++n) acc[a][b][m][n] = (f32x4){0.f, 0.f, 0.f, 0.f};
    bf16x8 At[4][2], B0[2][2], B1[2][2];
    const char* cA = (const char*)g.A + (size_t)cur.pm * tstep; const char* cB = (const char*)g.Bt + (size_t)cur.pn * tstep;
    S.a_ready(cur);
    if constexpr (SP2) {
        PG8_STAGE(PG8_SB(0, 0), cB, voffB); PG8_STAGE(PG8_SB(0, 1), cB + hstep, voffB); PG8_STAGE(PG8_SA(0, 0), cA, voffA); PG8_STAGE(PG8_SA(0, 1), cA + hstep, voffA);
        if (wr == 1) PG8_BAR;
        PG8_WAIT_V(2); PG8_BAR;
        PG8_STAGE(PG8_SB(1, 0), cB + kstep, voffB); PG8_STAGE(PG8_SA(1, 0), cA + kstep, voffA); PG8_STAGE(PG8_SB(1, 1), cB + hstep + kstep, voffB);
        PG8_WAIT_V(6); PG8_BAR;
    } else {
        PG8_STAGE(PG8_SB(0, 0), cB, voffB); PG8_STAGE(PG8_SA(0, 0), cA, voffA); PG8_STAGE(PG8_SB(0, 1), cB + hstep, voffB); PG8_STAGE(PG8_SA(0, 1), cA + hstep, voffA);
        if (wr == 1) PG8_BAR;
        PG8_WAIT_V(4); PG8_BAR;
        PG8_STAGE(PG8_SB(1, 0), cB + kstep, voffB); PG8_STAGE(PG8_SA(1, 0), cA + kstep, voffA); PG8_STAGE(PG8_SB(1, 1), cB + hstep + kstep, voffB);
        PG8_WAIT_V(6); PG8_BAR;
    }
    for (;;) {
        const bool has_next = S.next(ui + 1, nxt);
        const char* nA = has_next ? (const char*)g.A + (size_t)nxt.pm * tstep : cA; const char* nB = has_next ? (const char*)g.Bt + (size_t)nxt.pn * tstep : cB;
        for (int t = 0; t < nt; t += 2) {
            const bool last = (t == nt - 2);
            const char* a1 = cA + (size_t)(t + 1) * kstep;
            const char* a2 = last ? nA : cA + (size_t)(t + 2) * kstep; const char* b2 = last ? nB : cB + (size_t)(t + 2) * kstep;
            const char* a3 = a2 + kstep; const char* b3 = b2 + kstep;
            if (last && has_next) S.a_ready(nxt);
            if constexpr (SP2) {
            PG8_LDB(B0, 0, 0); PG8_LDB(B1, 0, 1); PG8_SCHED; PG8_LDA(At, 0, 0); PG8_STAGE(PG8_SA(1, 1), a1 + hstep, voffA);
            PG8_WAIT_V(8); PG8_WAIT_L(0); PG8_BAR; PG8_MMA(0, 0, At, B0); PG8_MMA(0, 1, At, B1); PG8_BAR; PG8_SCHED;
            PG8_LDA(At, 0, 1); PG8_STAGE(PG8_SB(0, 0), b2, voffB); PG8_STAGE(PG8_SB(0, 1), b2 + hstep, voffB); PG8_STAGE(PG8_SA(0, 0), a2, voffA);
            PG8_WAIT_V(8); PG8_WAIT_L(0); PG8_BAR; PG8_MMA(1, 0, At, B0); PG8_MMA(1, 1, At, B1); PG8_BAR; PG8_SCHED;
            PG8_LDB(B0, 1, 0); PG8_LDB(B1, 1, 1); PG8_SCHED; PG8_LDA(At, 1, 0); PG8_STAGE(PG8_SA(0, 1), a2 + hstep, voffA);
            PG8_WAIT_V(8); PG8_WAIT_L(0); PG8_BAR; PG8_MMA(0, 0, At, B0); PG8_MMA(0, 1, At, B1); PG8_BAR; PG8_SCHED;
            PG8_LDA(At, 1, 1); PG8_STAGE(PG8_SB(1, 0), b3, voffB); PG8_STAGE(PG8_SB(1, 1), b3 + hstep, voffB); PG8_STAGE(PG8_SA(1, 0), a3, voffA);
            PG8_WAIT_V(8); PG8_WAIT_L(0); PG8_BAR; PG8_MMA(1, 0, At, B0); PG8_MMA(1, 1, At, B1); PG8_BAR; PG8_SCHED;
            } else {
            PG8_LDB(B0, 0, 0); PG8_SCHED; PG8_LDA(At, 0, 0); PG8_STAGE(PG8_SA(1, 1), a1 + hstep, voffA);
            PG8_WAIT_L(8); PG8_BAR; PG8_WAIT_L(0); PG8_MMA(0, 0, At, B0); PG8_BAR; PG8_SCHED;
            PG8_LDB(B1, 0, 1); PG8_STAGE(PG8_SB(0, 0), b2, voffB);
            PG8_BAR; PG8_WAIT_L(0); PG8_MMA(0, 1, At, B1); PG8_BAR;
            PG8_LDA(At, 0, 1); PG8_STAGE(PG8_SA(0, 0), a2, voffA);
            PG8_BAR; PG8_WAIT_L(0); PG8_MMA(1, 0, At, B0); PG8_BAR; PG8_SCHED;
            PG8_STAGE(PG8_SB(0, 1), b2 + hstep, voffB);
            PG8_WAIT_V(6); PG8_BAR; PG8_MMA(1, 1, At, B1); PG8_BAR;
            PG8_LDB(B0, 1, 0); PG8_SCHED; PG8_LDA(At, 1, 0); PG8_STAGE(PG8_SA(0, 1), a2 + hstep, voffA);
            PG8_WAIT_L(8); PG8_BAR; PG8_WAIT_L(0); PG8_MMA(0, 0, At, B0); PG8_BAR; PG8_SCHED;
            PG8_LDB(B1, 1, 1); PG8_STAGE(PG8_SB(1, 0), b3, voffB);
            PG8_BAR; PG8_WAIT_L(0); PG8_MMA(0, 1, At, B1); PG8_BAR;
            PG8_LDA(At, 1, 1); PG8_STAGE(PG8_SA(1, 0), a3, voffA);
            PG8_BAR; PG8_WAIT_L(0); PG8_MMA(1, 0, At, B0); PG8_BAR; PG8_SCHED;
            PG8_STAGE(PG8_SB(1, 1), b3 + hstep, voffB);
            PG8_WAIT_V(6); PG8_BAR; PG8_MMA(1, 1, At, B1); PG8_BAR;
            }
        }
        if constexpr (ALIGN_EPI) { if (wr == 0) PG8_BAR; }
        if constexpr (!Epi::AFTER_DRAIN) { E(acc, cur, wr, wc, fr, fq); S.done(cur); }
        if (!has_next) break;
#pragma unroll
        for (int a = 0; a < 2; ++a)
#pragma unroll
            for (int b = 0; b < 2; ++b)
#pragma unroll
                for (int m = 0; m < 4; ++m)
#pragma unroll
                    for (int n = 0; n < 2; ++n) acc[a][b][m][n] = (f32x4){0.f, 0.f, 0.f, 0.f};
        cur = nxt; cA = nA; cB = nB; ++ui;
        if constexpr (ALIGN_EPI) { if (wr == 1) PG8_BAR; }
    }
    PG8_WAIT_V(0);
    if constexpr (!ALIGN_EPI) { if (wr == 0) PG8_BAR; }
    PG8_BAR;
    if constexpr (Epi::AFTER_DRAIN) { E.fused(acc, cur, wr, wc, fr, fq, lds, wid, lane); S.done(cur); }
#undef PG8_SA
#undef PG8_SB
#undef PG8_STAGE
#undef PG8_LDA
#undef PG8_LDB
#undef PG8_MMA
#undef PG8_WAIT_V
#undef PG8_WAIT_L
#undef PG8_BAR
#undef PG8_SCHED
}
}

#define LAS __attribute__((address_space(3)))
typedef unsigned short bf16_t;
typedef short bf16x8 __attribute__((ext_vector_type(8)));
typedef short s16x4 __attribute__((ext_vector_type(4)));
typedef float f32x4 __attribute__((ext_vector_type(4)));
typedef float f32x16 __attribute__((ext_vector_type(16)));
typedef unsigned u32x4 __attribute__((ext_vector_type(4)));
typedef unsigned u32x2 __attribute__((ext_vector_type(2)));

constexpr int S = 16384, DM = 1024, DFF = 2816, NPROJ = 3840, NGATE = 3072, NDEPTH = 4;
constexpr int NVT = 1152;
constexpr float LOG2E = 1.4426950408889634f;
constexpr float QSCALE = 0.125f * LOG2E;
constexpr float NEGBIG = -1e30f;
constexpr int NSTEP_PER_LAYER = 8, NSTEPS = 1 + NDEPTH * NSTEP_PER_LAYER + 1;

struct Params {
    const float *x, *w_in, *w_branch, *w_gate, *b_gate, *w_o, *norm_g, *final_g, *ffn_w_gate, *ffn_w_up, *ffn_w_down, *na_rpb, *diff_lambda, *diff_subln_g, *gqa_sink, *rel_bias;
    float* out; unsigned char* ws; int step_lo, step_hi;
};

constexpr size_t E_WGU = (size_t)2 * DFF * DM, E_WD = (size_t)DM * DFF, E_WING = (size_t)(NPROJ + NGATE) * DM, E_WB = (size_t)DM * 512, E_WO = (size_t)DM * DM;
constexpr size_t O_WGU0 = 0, O_WD0 = O_WGU0 + E_WGU, O_WING = O_WD0 + E_WD, O_WB = O_WING + E_WING, O_WO = O_WB + 3 * E_WB, O_WGU1 = O_WO + E_WO, O_WD1 = O_WGU1 + E_WGU, E_WTOT = O_WD1 + E_WD;
constexpr size_t B_W = 0, B_XB = B_W + 2 * E_WTOT * 2, B_PROJ = B_XB + (size_t)S * DM * 2, B_G = B_PROJ + (size_t)S * NPROJ * 2, B_Y = B_G + (size_t)S * NGATE * 2,
                 B_VT = B_Y + 3 * (size_t)S * 512 * 2, B_SSQ = B_VT + (size_t)NVT * S * 2, B_MRG = B_PROJ  , B_BAR = B_SSQ + (size_t)12 * S * 16 * 4, B_END = B_BAR + 16384;
constexpr int LDS_BYTES = 131072 + 1024;

__device__ __forceinline__ unsigned pk2(float lo, float hi) { return pg8::cvt_pk_bf16(lo, hi); }
__device__ __forceinline__ float bflo(unsigned w) { return __uint_as_float(w << 16); }
__device__ __forceinline__ float bfhi(unsigned w) { return __uint_as_float(w & 0xffff0000u); }
__device__ __forceinline__ float fast_exp2(float x) { return __builtin_amdgcn_exp2f(x); }
__device__ __forceinline__ float fast_rcp(float x) { return __builtin_amdgcn_rcpf(x); }
__device__ __forceinline__ float wave_sum(float v) {
#pragma unroll
    for (int o = 1; o < 64; o <<= 1) v += __shfl_xor(v, o);
    return v;
}
__device__ __forceinline__ float xhalf_sum(float v) { auto rr = __builtin_amdgcn_permlane32_swap(__float_as_uint(v), __float_as_uint(v), false, false); return __uint_as_float(rr[0]) + __uint_as_float(rr[1]); }
__device__ __forceinline__ float xhalf_max(float v) { auto rr = __builtin_amdgcn_permlane32_swap(__float_as_uint(v), __float_as_uint(v), false, false); return fmaxf(__uint_as_float(rr[0]), __uint_as_float(rr[1])); }

__device__ __forceinline__ float rstd_of(const float* ssq, int row) {
    const f32x4* q = (const f32x4*)(ssq + (size_t)row * 16); const f32x4 a = q[0], b = q[1], c = q[2], d = q[3];
    const float t = (((a.x + a.y) + (a.z + a.w)) + ((b.x + b.y) + (b.z + b.w))) + (((c.x + c.y) + (c.z + c.w)) + ((d.x + d.y) + (d.z + d.w)));
    return 1.0f / sqrtf(t * (1.0f / DM) + 1e-6f); }
struct EpiSwiGLU {
    static constexpr bool PERM = true, AFTER_DRAIN = false;
    bf16_t* O; const float* ssq;
    __device__ __forceinline__ void operator()(const pg8::f32x4 (&acc)[2][2][4][2], const pg8::Unit& u, int wr, int wc, int fr, int fq) const {
        const int row0 = u.pm * 256 + wr * 64 + fr, col0 = u.pn * 128 + wc * 32 + 8 * fq;
#pragma unroll
        for (int ai = 0; ai < 2; ++ai)
#pragma unroll
            for (int m = 0; m < 4; ++m) {
                const int row = row0 + ai * 128 + m * 16; const float rs = rstd_of(ssq, row);
                bf16_t* dst = O + (size_t)row * DFF + col0;
                float v[8];
#pragma unroll
                for (int n = 0; n < 2; ++n)
#pragma unroll
                    for (int j = 0; j < 4; ++j) { const float g = acc[ai][0][m][n][j] * rs, uu = acc[ai][1][m][n][j] * rs; v[n * 4 + j] = g * fast_rcp(1.0f + fast_exp2(-g * LOG2E)) * uu; }
                u32x4 w; w.x = pk2(v[0], v[1]); w.y = pk2(v[2], v[3]); w.z = pk2(v[4], v[5]); w.w = pk2(v[6], v[7]);
                *(u32x4*)dst = w;
            }
    }
};
struct EpiResid {
    static constexpr bool PERM = true, AFTER_DRAIN = false;
    const float* base; float* out; bf16_t* xb; float* ssq; float alpha;
    __device__ __forceinline__ void operator()(const pg8::f32x4 (&acc)[2][2][4][2], const pg8::Unit& u, int wr, int wc, int fr, int fq) const {
        const int row0 = u.pm * 256 + wr * 64 + fr, col0 = u.pn * 256 + wc * 32 + 8 * fq;
#pragma unroll
        for (int ai = 0; ai < 2; ++ai) {
            f32x4 bv[4][2][2];
#pragma unroll
            for (int m = 0; m < 4; ++m)
#pragma unroll
                for (int bj = 0; bj < 2; ++bj) { const size_t off = (size_t)(row0 + ai * 128 + m * 16) * DM + col0 + bj * 128; bv[m][bj][0] = *(const f32x4*)(base + off); bv[m][bj][1] = *(const f32x4*)(base + off + 4); }
#pragma unroll
            for (int m = 0; m < 4; ++m) {
                const int row = row0 + ai * 128 + m * 16; float ss = 0.f;
#pragma unroll
                for (int bj = 0; bj < 2; ++bj) {
                    const size_t off = (size_t)row * DM + col0 + bj * 128;
                    const f32x4 x0 = bv[m][bj][0] + acc[ai][bj][m][0] * alpha, x1 = bv[m][bj][1] + acc[ai][bj][m][1] * alpha;
                    *(f32x4*)(out + off) = x0; *(f32x4*)(out + off + 4) = x1;
                    u32x4 w; w.x = pk2(x0[0], x0[1]); w.y = pk2(x0[2], x0[3]); w.z = pk2(x1[0], x1[1]); w.w = pk2(x1[2], x1[3]);
                    *(u32x4*)(xb + off) = w;
                    ss += ((x0[0] * x0[0] + x0[1] * x0[1]) + (x0[2] * x0[2] + x0[3] * x0[3])) + ((x1[0] * x1[0] + x1[1] * x1[1]) + (x1[2] * x1[2] + x1[3] * x1[3]));
                }
                ss += __shfl_xor(ss, 16); ss += __shfl_xor(ss, 32);
                if (ssq && fq == 0) ssq[(size_t)row * 16 + u.pn * 4 + wc] = ss;
            }
            asm volatile("" ::: "memory");
        }
    }
};
struct EpiProjGate {
    static constexpr bool PERM = true, AFTER_DRAIN = false;
    bf16_t* proj; bf16_t* G; const float* bg; const float* ssq; bf16_t* vt;
    __device__ __forceinline__ void operator()(const pg8::f32x4 (&acc)[2][2][4][2], const pg8::Unit& u, int wr, int wc, int fr, int fq) const {
        const int row0 = u.pm * 256 + wr * 64 + fr;
        if (u.pn < 15) {
            const float sc = ((u.pn % 6) < 2) ? QSCALE : 1.0f;
            const int col0 = u.pn * 256 + wc * 32 + 8 * fq;
            const bool vt_all = (u.pn == 4) | (u.pn == 5) | (u.pn == 10) | (u.pn == 11), vt_half = (u.pn == 14);
            const int vrow0 = (u.pn <= 5 ? (u.pn - 4) * 256 : (u.pn <= 11 ? 512 + (u.pn - 10) * 256 : 1024 - 128)) + wc * 32 + 8 * fq;
#pragma unroll
            for (int ai = 0; ai < 2; ++ai)
#pragma unroll
                for (int m = 0; m < 4; ++m) {
                    const int row = row0 + ai * 128 + m * 16; const float rs = rstd_of(ssq, row) * sc;
#pragma unroll
                    for (int bj = 0; bj < 2; ++bj) {
                        const pg8::f32x4 v0 = acc[ai][bj][m][0] * rs, v1 = acc[ai][bj][m][1] * rs;
                        u32x4 w; w.x = pk2(v0[0], v0[1]); w.y = pk2(v0[2], v0[3]); w.z = pk2(v1[0], v1[1]); w.w = pk2(v1[2], v1[3]);
                        if (vt_all || (vt_half && bj == 1)) {
                            bf16_t* vp = vt + (size_t)(vrow0 + bj * 128) * S + row;
                            vp[0 * (size_t)S] = (bf16_t)(w.x & 0xffffu); vp[1 * (size_t)S] = (bf16_t)(w.x >> 16); vp[2 * (size_t)S] = (bf16_t)(w.y & 0xffffu); vp[3 * (size_t)S] = (bf16_t)(w.y >> 16);
                            vp[4 * (size_t)S] = (bf16_t)(w.z & 0xffffu); vp[5 * (size_t)S] = (bf16_t)(w.z >> 16); vp[6 * (size_t)S] = (bf16_t)(w.w & 0xffffu); vp[7 * (size_t)S] = (bf16_t)(w.w >> 16);
                        } else {
                            *(u32x4*)(proj + (size_t)row * NPROJ + col0 + bj * 128) = w;
                        }
                    }
                }
        } else {
            const int col0 = (u.pn - 15) * 256 + wc * 32 + 8 * fq;
            f32x4 bb[2][2];
#pragma unroll
            for (int bj = 0; bj < 2; ++bj) { bb[bj][0] = *(const f32x4*)(bg + col0 + bj * 128); bb[bj][1] = *(const f32x4*)(bg + col0 + bj * 128 + 4); }
#pragma unroll
            for (int ai = 0; ai < 2; ++ai)
#pragma unroll
                for (int m = 0; m < 4; ++m) {
                    const int row = row0 + ai * 128 + m * 16; const float rs = rstd_of(ssq, row);
#pragma unroll
                    for (int bj = 0; bj < 2; ++bj) {
                        float v[8];
#pragma unroll
                        for (int j = 0; j < 4; ++j) { v[j] = fast_rcp(1.0f + fast_exp2(-(acc[ai][bj][m][0][j] * rs + bb[bj][0][j]) * LOG2E)); v[4 + j] = fast_rcp(1.0f + fast_exp2(-(acc[ai][bj][m][1][j] * rs + bb[bj][1][j]) * LOG2E)); }
                        u32x4 w; w.x = pk2(v[0], v[1]); w.y = pk2(v[2], v[3]); w.z = pk2(v[4], v[5]); w.w = pk2(v[6], v[7]);
                        *(u32x4*)(G + (size_t)row * NGATE + col0 + bj * 128) = w;
                    }
                }
        }
    }
};
struct EpiBranch {
    static constexpr bool PERM = true, AFTER_DRAIN = false;
    const bf16_t* G; bf16_t* mrg; int coloff; bool first;
    __device__ __forceinline__ void operator()(const pg8::f32x4 (&acc)[2][2][4][2], const pg8::Unit& u, int wr, int wc, int fr, int fq) const {
        const int row0 = u.pm * 256 + wr * 64 + fr, col0 = u.pn * 256 + wc * 32 + 8 * fq;
#pragma unroll
        for (int ai = 0; ai < 2; ++ai) {
            u32x4 gv[4][2], ov[4][2];
#pragma unroll
            for (int m = 0; m < 4; ++m)
#pragma unroll
                for (int bj = 0; bj < 2; ++bj) {
                    const int row = row0 + ai * 128 + m * 16;
                    gv[m][bj] = *(const u32x4*)(G + (size_t)row * NGATE + coloff + col0 + bj * 128);
                    ov[m][bj] = (u32x4){0u, 0u, 0u, 0u}; if (!first) ov[m][bj] = *(const u32x4*)(mrg + (size_t)row * DM + col0 + bj * 128);
                }
#pragma unroll
            for (int m = 0; m < 4; ++m)
#pragma unroll
                for (int bj = 0; bj < 2; ++bj) {
                    const int row = row0 + ai * 128 + m * 16;
                    const u32x4 g = gv[m][bj], o = ov[m][bj]; const pg8::f32x4 a0 = acc[ai][bj][m][0], a1 = acc[ai][bj][m][1];
                    u32x4 w; w.x = pk2(bflo(o.x) + bflo(g.x) * a0[0], bfhi(o.x) + bfhi(g.x) * a0[1]); w.y = pk2(bflo(o.y) + bflo(g.y) * a0[2], bfhi(o.y) + bfhi(g.y) * a0[3]);
                    w.z = pk2(bflo(o.z) + bflo(g.z) * a1[0], bfhi(o.z) + bfhi(g.z) * a1[1]); w.w = pk2(bflo(o.w) + bflo(g.w) * a1[2], bfhi(o.w) + bfhi(g.w) * a1[3]);
                    *(u32x4*)(mrg + (size_t)row * DM + col0 + bj * 128) = w;
                }
            asm volatile("" ::: "memory");
        }
    }
};

__device__ __forceinline__ void transpose_tile(const float* src, int srcN, const float* gk, bf16_t* dst, int dstK, LAS float* scr, int lane) {
    float tv[32];
#pragma unroll
    for (int i = 0; i < 32; ++i) tv[i] = src[(size_t)(2 * i + (lane >> 5)) * srcN + (lane & 31)];
    if (gk) {
#pragma unroll
        for (int i = 0; i < 32; ++i) tv[i] *= gk[2 * i + (lane >> 5)];
    }
#pragma unroll
    for (int i = 0; i < 32; ++i) scr[(2 * i + (lane >> 5)) * 33 + (lane & 31)] = tv[i];
    asm volatile("s_waitcnt lgkmcnt(0)" ::: "memory");
    const int c = lane & 7;
#pragma unroll
    for (int j = 0; j < 4; ++j) {
        const int n = (lane >> 3) + 8 * j; const LAS float* s = scr + (8 * c) * 33 + n;
        u32x4 o; o.x = pk2(s[0 * 33], s[1 * 33]); o.y = pk2(s[2 * 33], s[3 * 33]); o.z = pk2(s[4 * 33], s[5 * 33]); o.w = pk2(s[6 * 33], s[7 * 33]);
        *(u32x4*)(dst + (size_t)n * dstK + 8 * c) = o;
    }
    asm volatile("s_waitcnt lgkmcnt(0)" ::: "memory");
}
constexpr int CV_I_GU = (2 * DFF / 32) * (DM / 64), CV_I_D = (DM / 32) * (DFF / 64), CV_I_ING = ((NPROJ + NGATE) / 32) * (DM / 64), CV_I_B = (DM / 32) * (512 / 64), CV_I_O = (DM / 32) * (DM / 64);
constexpr int CV_NITEMS = 2 * CV_I_GU + 2 * CV_I_D + CV_I_ING + 3 * CV_I_B + CV_I_O;
constexpr int CV_CUT1 = (CV_NITEMS * 2) / 5, CV_CUT2 = (CV_NITEMS * 4) / 5;
__device__ __forceinline__ void convert_layer(const Params& p, int l, LAS unsigned char* lds, int it_lo, int it_hi, int worker, int nworkers) {
    const int tid = pg8::pg8_opaque_tid(), lane = tid & 63, wid = __builtin_amdgcn_readfirstlane(tid >> 6);
    LAS float* scr = (LAS float*)(lds + wid * 8448);
    bf16_t* W = (bf16_t*)(p.ws + B_W) + (size_t)(l & 1) * E_WTOT;
    const float* ng = p.norm_g + (size_t)l * 3 * DM;
    constexpr int I_GU = CV_I_GU, I_D = CV_I_D, I_ING = CV_I_ING, I_B = CV_I_B;
    for (int it = it_lo + worker * 8 + wid; it < it_hi; it += nworkers * 8) {
        int r = it;
        if (r < 2 * I_GU) {
            const int f = r / I_GU; r -= f * I_GU; const int nb = r / (DM / 64), kb = r % (DM / 64), n0 = nb * 32, k0 = kb * 64;
            const int pn = n0 >> 8, w = n0 & 255; const float* src = ((w < 128) ? p.ffn_w_gate : p.ffn_w_up) + (size_t)(l * 2 + f) * DM * DFF;
            transpose_tile(src + (size_t)k0 * DFF + pn * 128 + (w & 127), DFF, ng + (f ? 2 : 0) * DM + k0, W + (f ? O_WGU1 : O_WGU0) + (size_t)n0 * DM + k0, DM, scr, lane); continue; }
        r -= 2 * I_GU;
        if (r < 2 * I_D) {
            const int f = r / I_D; r -= f * I_D; const int nb = r / (DFF / 64), kb = r % (DFF / 64), n0 = nb * 32, k0 = kb * 64;
            const float* src = p.ffn_w_down + (size_t)(l * 2 + f) * DFF * DM;
            transpose_tile(src + (size_t)k0 * DM + n0, DM, nullptr, W + (f ? O_WD1 : O_WD0) + (size_t)n0 * DFF + k0, DFF, scr, lane); continue; }
        r -= 2 * I_D;
        if (r < I_ING) {
            const int nb = r / (DM / 64), kb = r % (DM / 64), n0 = nb * 32, k0 = kb * 64;
            if (n0 < NPROJ) transpose_tile(p.w_in + (size_t)l * DM * NPROJ + (size_t)k0 * NPROJ + n0, NPROJ, ng + DM + k0, W + O_WING + (size_t)n0 * DM + k0, DM, scr, lane);
            else transpose_tile(p.w_gate + (size_t)l * DM * NGATE + (size_t)k0 * NGATE + (n0 - NPROJ), NGATE, ng + DM + k0, W + O_WING + (size_t)n0 * DM + k0, DM, scr, lane);
            continue; }
        r -= I_ING;
        if (r < 3 * I_B) {
            const int i = r / I_B; r -= i * I_B; const int nb = r / 8, kb = r % 8, n0 = nb * 32, k0 = kb * 64;
            transpose_tile(p.w_branch + (size_t)(l * 3 + i) * 512 * DM + (size_t)k0 * DM + n0, DM, nullptr, W + O_WB + (size_t)i * E_WB + (size_t)n0 * 512 + k0, 512, scr, lane); continue; }
        r -= 3 * I_B;
        {
            const int nb = r / (DM / 64), kb = r % (DM / 64), n0 = nb * 32, k0 = kb * 64;
            transpose_tile(p.w_o + (size_t)l * DM * DM + (size_t)k0 * DM + n0, DM, nullptr, W + O_WO + (size_t)n0 * DM + k0, DM, scr, lane); }
    }
}

__device__ __forceinline__ void prologue_rows(const float* x, bf16_t* xb, float* ssq) {
    const int tid = pg8::pg8_opaque_tid(), lane = tid & 63, wid = __builtin_amdgcn_readfirstlane(tid >> 6);
    const int gw = blockIdx.x * 8 + wid, NGW = gridDim.x * 8;
    for (int row0 = gw; row0 < S; row0 += 2 * NGW) {
        f32x4 v[2][4];
#pragma unroll
        for (int h = 0; h < 2; ++h)
#pragma unroll
            for (int j = 0; j < 4; ++j) v[h][j] = *((const f32x4*)(x + (size_t)(row0 + h * NGW) * DM) + lane + 64 * j);
#pragma unroll
        for (int h = 0; h < 2; ++h) {
            const int row = row0 + h * NGW; u32x2* o = (u32x2*)(xb + (size_t)row * DM) + lane; float ss = 0.f;
#pragma unroll
            for (int j = 0; j < 4; ++j) { const f32x4 t = v[h][j]; ss += (t.x * t.x + t.y * t.y) + (t.z * t.z + t.w * t.w); u32x2 w; w.x = pk2(t.x, t.y); w.y = pk2(t.z, t.w); o[64 * j] = w; }
            ss = wave_sum(ss);
            if (lane < 16) ssq[(size_t)row * 16 + lane] = (lane == 0) ? ss : 0.f;
        }
    }
}
__device__ __forceinline__ void final_norm(float* x, const float* g) {
    const int tid = pg8::pg8_opaque_tid(), lane = tid & 63, wid = __builtin_amdgcn_readfirstlane(tid >> 6);
    const int gw = blockIdx.x * 8 + wid, NGW = gridDim.x * 8;
    f32x4 gv[4];
#pragma unroll
    for (int j = 0; j < 4; ++j) gv[j] = *((const f32x4*)g + lane + 64 * j);
    for (int row0 = gw; row0 < S; row0 += 2 * NGW) {
        f32x4 v[2][4];
#pragma unroll
        for (int h = 0; h < 2; ++h)
#pragma unroll
            for (int j = 0; j < 4; ++j) v[h][j] = *((const f32x4*)(x + (size_t)(row0 + h * NGW) * DM) + lane + 64 * j);
#pragma unroll
        for (int h = 0; h < 2; ++h) {
            f32x4* xr = (f32x4*)(x + (size_t)(row0 + h * NGW) * DM) + lane; float ss = 0.f;
#pragma unroll
            for (int j = 0; j < 4; ++j) ss += (v[h][j].x * v[h][j].x + v[h][j].y * v[h][j].y) + (v[h][j].z * v[h][j].z + v[h][j].w * v[h][j].w);
            const float rstd = 1.0f / sqrtf(wave_sum(ss) * (1.0f / DM) + 1e-6f);
#pragma unroll
            for (int j = 0; j < 4; ++j) xr[64 * j] = v[h][j] * rstd * gv[j];
        }
    }
}

__device__ __forceinline__ float max2m(float a, float b) { return __builtin_amdgcn_fmed3f(a, b, __builtin_inff()); }
__device__ __forceinline__ float max3f(float a, float b, float c) { return max2m(max2m(a, b), c); }
__device__ __forceinline__ int crow(int r, int hi) { return (r & 3) + 8 * (r >> 2) + 4 * hi; }
__device__ __forceinline__ int t5_bucket(int rel) {
    const int n = rel < 0 ? -rel : rel; int b;
    if (n < 8) b = n; else if (n < 12) b = 8; else if (n < 16) b = 9; else if (n < 23) b = 10; else if (n < 32) b = 11; else if (n < 46) b = 12; else if (n < 64) b = 13; else if (n < 91) b = 14; else b = 15;
    return b + (rel > 0 ? 16 : 0);
}
typedef short v4i16_t __attribute__((ext_vector_type(4)));
__device__ __forceinline__ s16x4 tr_read(const LAS unsigned char* p) { return __builtin_bit_cast(s16x4, __builtin_amdgcn_ds_read_tr16_b64_v4i16((LAS v4i16_t*)p)); }

template <int MODE, bool FROZEN = false>
__device__ __forceinline__ bool attn_unit(LAS unsigned char* lds, const Params& p, int l, int ua, int ub) {
    constexpr int KW = (MODE == 1) ? 128 : 64, DV = (MODE == 1) ? 128 : 64, NB = DV / 32;
    constexpr int KPB = KW * 2 + 16, VTP = 144, KBUF = 64 * KPB, VBUF = DV * VTP;
    constexpr int OFF_K = 0, OFF_V = 2 * KBUF, OFF_LUT = 2 * KBUF + 2 * VBUF;
    constexpr int KCH = KW / 8, NKC = 64 * KCH / 512, NVC = DV * 8 / 512;
    const int tid = pg8::pg8_opaque_tid(), lane = tid & 63, wid = __builtin_amdgcn_readfirstlane(tid >> 6), r32 = lane & 31, hi = lane >> 5;
    const bf16_t* proj = (const bf16_t*)(p.ws + B_PROJ);
    const bf16_t* vtg = (const bf16_t*)(p.ws + B_VT);
    LAS float* lut = (LAS float*)(lds + OFF_LUT);

    int qtok0, qcol, kcol, vcol, kfo = 0, ocol = 0, kt0, NT, wt_lo = 0, wt_hi, lut_sel = 0, myrow = 0;
    bf16_t* obuf = (bf16_t*)(p.ws + B_Y) + (size_t)MODE * S * 512;
    float m_run = NEGBIG, l_run = 0.f, lam = 0.f, lam_init = 0.f;
    if constexpr (MODE == 0) {
        const int h = ua, R0 = ub * 4; myrow = R0 + (wid >> 1); qtok0 = myrow * 64 + (wid & 1) * 32;
        qcol = h * 64; kcol = 512 + h * 64; vcol = h * 64; ocol = h * 64;
        const int rs_first = min(max(R0 - 4, 0), 248), rs_last = min(max(R0 + 3 - 4, 0), 248), my_rs = min(max(myrow - 4, 0), 248);
        kt0 = rs_first * 64; NT = rs_last + 8 - rs_first; wt_lo = my_rs - rs_first; wt_hi = wt_lo + 8;
        for (int i = tid; i < 15 * 127; i += 512) { const int dr_ = i / 127, dc_ = min(max(i % 127 - 48, 0), 30); lut[i] = p.na_rpb[(size_t)(l * 8 + h) * 465 + dr_ * 31 + dc_] * LOG2E; }
    } else if constexpr (MODE == 1) {
        const int h = ua, qb = ub, c = wid >> 2; qtok0 = qb * 128 + (wid & 3) * 32;
        qcol = 1536 + h * 128 + c * 64; kcol = 2048 + h * 128; kfo = c * 64; vcol = 512 + h * 128; ocol = h * 128;
        kt0 = 0; NT = S / 64; wt_hi = NT;
        for (int i = tid; i < 449; i += 512) lut[i] = p.rel_bias[t5_bucket(i - 224) * 12 + h] * LOG2E;
        const float* lq = p.diff_lambda + (size_t)l * 256;
        const float s1 = wave_sum(lq[lane] * lq[64 + lane]), s2 = wave_sum(lq[128 + lane] * lq[192 + lane]);
        lam_init = 0.8f - 0.6f * expf(-0.3f * (float)l);
        lam = expf(s1) - expf(s2) + lam_init;
    } else {
        const int g = ua, qb = ub, hq = g * 4 + (wid >> 1); qtok0 = qb * 64 + (wid & 1) * 32; lut_sel = wid >> 1;
        qcol = 3072 + hq * 64; kcol = 3584 + g * 64; vcol = 1024 + g * 64; ocol = hq * 64;
        const int tlo = max(qb - 2, 0), thi = min(qb + 2, S / 64 - 1); kt0 = tlo * 64; NT = thi - tlo + 1; wt_hi = NT;
        for (int i = tid; i < 4 * 449; i += 512) { const int hh = i / 449, rel = i % 449 - 224; lut[i] = (rel >= -128 && rel <= 128) ? p.rel_bias[t5_bucket(rel) * 12 + 4 + g * 4 + hh] * LOG2E : NEGBIG; }
        m_run = p.gqa_sink[l * 8 + hq] * LOG2E; l_run = (hi == 0) ? 1.0f : 0.0f;
    }
    bf16x8 qf[4];
    { const bf16_t* qp = proj + (size_t)(qtok0 + r32) * NPROJ + qcol + 8 * hi;
#pragma unroll
      for (int d0 = 0; d0 < 4; ++d0) qf[d0] = *(const bf16x8*)(qp + 16 * d0); }
    f32x16 o[NB];
#pragma unroll
    for (int nb = 0; nb < NB; ++nb)
#pragma unroll
        for (int r = 0; r < 16; ++r) o[nb][r] = 0.f;

    u32x4 kr[NKC], vr[NVC];
    unsigned ksrc[NKC], vsrc[NVC]; int kdst[NKC], vdst[NVC];
    const bf16_t* kvbase = proj + (size_t)kt0 * NPROJ;
#pragma unroll
    for (int i = 0; i < NKC; ++i) { const int cid = tid + 512 * i, row = cid / KCH, ch = cid % KCH; ksrc[i] = (unsigned)(row * NPROJ + kcol + ch * 8); kdst[i] = OFF_K + row * KPB + ch * 16; }
#pragma unroll
    for (int i = 0; i < NVC; ++i) { const int cid = tid + 512 * i, row = cid >> 3, ch = cid & 7; vsrc[i] = (unsigned)((vcol + row) * S + ch * 8); vdst[i] = OFF_V + row * VTP + (ch >> 1) * 32 + (ch & 1) * 8; }
    const bf16_t* vtbase = vtg + kt0;
    {
        u32x4 k1[NKC];
#pragma unroll
        for (int i = 0; i < NKC; ++i) { kr[i] = *(const u32x4*)(kvbase + ksrc[i]); k1[i] = *(const u32x4*)(kvbase + (size_t)64 * NPROJ + ksrc[i]); }
#pragma unroll
        for (int i = 0; i < NVC; ++i) vr[i] = *(const u32x4*)(vtbase + vsrc[i]);
#pragma unroll
        for (int i = 0; i < NKC; ++i) { *(LAS u32x4*)(lds + kdst[i]) = kr[i]; *(LAS u32x4*)(lds + kdst[i] + KBUF) = k1[i]; }
#pragma unroll
        for (int i = 0; i < NVC; ++i) { *(LAS u32x2*)(lds + vdst[i]) = (u32x2){vr[i].x, vr[i].y}; *(LAS u32x2*)(lds + vdst[i] + 16) = (u32x2){vr[i].z, vr[i].w}; }
#pragma unroll
        for (int i = 0; i < NKC; ++i) kr[i] = *(const u32x4*)(kvbase + (size_t)2 * 64 * NPROJ + ksrc[i]);
#pragma unroll
        for (int i = 0; i < NVC; ++i) vr[i] = *(const u32x4*)(vtbase + 64 + vsrc[i]);
    }
    __syncthreads();

    const int qpos = qtok0 + r32;
    const int i16 = lane & 15, q4 = i16 >> 2, p4 = i16 & 3, blk = (lane >> 4) & 1;
    const int vlane_off = r32 * VTP + hi * 16;
    const int klane_off = r32 * KPB + (kfo + 8 * hi) * 2;

    f32x16 sB0, sB1; float cbB = 0.f; bool fastB = false;
#define ATT_QK(tt) do { const LAS unsigned char* Kb_ = lds + OFF_K + ((tt) & 1) * KBUF + klane_off; \
        f32x16 z0_, z1_; _Pragma("unroll") for (int r = 0; r < 16; ++r) { z0_[r] = 0.f; z1_[r] = 0.f; } \
        _Pragma("unroll") for (int d0 = 0; d0 < 4; ++d0) { \
            const bf16x8 k0_ = *(const LAS bf16x8*)(Kb_ + d0 * 32), k1_ = *(const LAS bf16x8*)(Kb_ + 32 * KPB + d0 * 32); \
            z0_ = __builtin_amdgcn_mfma_f32_32x32x16_bf16(k0_, qf[d0], z0_, 0, 0, 0); z1_ = __builtin_amdgcn_mfma_f32_32x32x16_bf16(k1_, qf[d0], z1_, 0, 0, 0); } \
        sB0 = z0_; sB1 = z1_; } while (0)
#define ATT_MAX3(dst) do { float tm_ = max3f(sB0[0], sB1[0], sB0[1]), tn_ = max3f(sB1[1], sB0[2], sB1[2]); \
        _Pragma("unroll") for (int r = 3; r < 15; r += 2) { tm_ = max3f(tm_, sB0[r], sB1[r]); tn_ = max3f(tn_, sB0[r + 1], sB1[r + 1]); } \
        tm_ = max3f(tm_, sB0[15], sB1[15]); dst = max3f(tm_, tn_, tn_); } while (0)
#define ATT_BIAS(tt, tmraw) do { const int ktok_ = kt0 + 64 * (tt); bool fast_ = false; cbB = 0.f; const float nm_ = FROZEN ? -m_run : 0.f; \
        if constexpr (MODE == 1) { if (ktok_ - (qtok0 + 31) >= 128) { cbB = cb_pos; fast_ = true; } else if (qtok0 - (ktok_ + 63) >= 128) { cbB = cb_neg; fast_ = true; } } \
        if (!fast_) { \
            if constexpr (MODE != 0) { \
                const LAS float* lp_ = lut + (ktok_ - qpos + 224 + 4 * hi + (MODE == 2 ? lut_sel * 449 : 0)); \
                _Pragma("unroll") for (int r = 0; r < 16; ++r) { const int cr_ = (r & 3) + 8 * (r >> 2); sB0[r] += lp_[cr_] + nm_; if ((r & 7) == 7) __builtin_amdgcn_sched_barrier(0); } \
                _Pragma("unroll") for (int r = 0; r < 16; ++r) { const int cr_ = (r & 3) + 8 * (r >> 2); sB1[r] += lp_[cr_ + 32] + nm_; if ((r & 7) == 7) __builtin_amdgcn_sched_barrier(0); } \
            } else { \
                if (!((tt) >= wt_lo && (tt) < wt_hi)) { _Pragma("unroll") for (int r = 0; r < 16; ++r) { sB0[r] = -INFINITY; sB1[r] = -INFINITY; } } \
                else { \
                    const int qc = (wid & 1) * 32 + r32, cs = min(max(qc - 8, 0), 48), dr = min(max((kt0 >> 6) + (tt) - myrow + 7, 0), 14); \
                    const LAS float* lp_ = lut + (dr * 127 + 63 - qc + 4 * hi); const int kb_ = 4 * hi - cs; \
                    _Pragma("unroll") for (int r = 0; r < 16; ++r) { const int cr_ = (r & 3) + 8 * (r >> 2); \
                        sB0[r] = ((unsigned)(kb_ + cr_) < 16u) ? sB0[r] + lp_[cr_] : NEGBIG; sB1[r] = ((unsigned)(kb_ + cr_ + 32) < 16u) ? sB1[r] + lp_[cr_ + 32] : NEGBIG; if ((r & 3) == 3) __builtin_amdgcn_sched_barrier(0); } \
                } } if constexpr (!FROZEN) ATT_MAX3(tmraw); } \
        fastB = fast_; \
    } while (0)
#define ATT_UPD(tmraw) do { \
        if constexpr (FROZEN) {              \
            if (fastB && __any(cbB != m_run)) { \
                const float f_ = fast_exp2(m_run - cbB); l_run *= f_; m_run = cbB; \
                _Pragma("unroll") for (int nb = 0; nb < NB; ++nb) _Pragma("unroll") for (int r = 0; r < 16; ++r) o[nb][r] *= f_; } \
        } else { \
            const float tm_ = xhalf_max(tmraw) + cbB; \
            if (__any(tm_ > m_run)) { \
                const float mn_ = fmaxf(m_run, tm_), f_ = fast_exp2(m_run - mn_); l_run *= f_; m_run = mn_; \
                _Pragma("unroll") for (int nb = 0; nb < NB; ++nb) _Pragma("unroll") for (int r = 0; r < 16; ++r) o[nb][r] *= f_; } } \
    } while (0)

    float cb_pos = 0.f, cb_neg = 0.f;
    if constexpr (MODE == 1) { cb_pos = lut[448]; cb_neg = lut[0]; }
    ATT_QK(0);
    if constexpr (FROZEN) m_run = cb_neg;
    { float tm0 = 0.f; if constexpr (!FROZEN) ATT_MAX3(tm0); ATT_BIAS(0, tm0); ATT_UPD(tm0); }
    __syncthreads();

    for (int t = 0; t < NT; ++t) {
        if (t + 2 < NT) {
#pragma unroll
            for (int i = 0; i < NKC; ++i) *(LAS u32x4*)(lds + kdst[i] + (t & 1) * KBUF) = kr[i];
        }
        if (t + 1 < NT) {
#pragma unroll
            for (int i = 0; i < NVC; ++i) { *(LAS u32x2*)(lds + vdst[i] + ((t + 1) & 1) * VBUF) = (u32x2){vr[i].x, vr[i].y}; *(LAS u32x2*)(lds + vdst[i] + ((t + 1) & 1) * VBUF + 16) = (u32x2){vr[i].z, vr[i].w}; }
        }
        {
            const size_t advk = (size_t)min(t + 3, NT - 1) * 64 * NPROJ, advv = (size_t)min(t + 2, NT - 1) * 64;
#pragma unroll
            for (int i = 0; i < NKC; ++i) kr[i] = *(const u32x4*)(kvbase + advk + ksrc[i]);
#pragma unroll
            for (int i = 0; i < NVC; ++i) vr[i] = *(const u32x4*)(vtbase + advv + vsrc[i]);
        }
        f32x16 sA0 = sB0, sA1 = sB1;
        const float c2 = cbB - m_run;
        const LAS unsigned char* Vb = lds + OFF_V + (t & 1) * VBUF + vlane_off;
        const LAS unsigned char* Kb = lds + OFF_K + ((t + 1) & 1) * KBUF + klane_off;
#define SA_(ks, j) ((((ks) >> 1) == 0) ? sA0[8 * ((ks) & 1) + (j)] : sA1[8 * ((ks) & 1) + (j)])
#define EXPCVT(ks, PF, PSUM) do { float x_[8]; _Pragma("unroll") for (int j = 0; j < 8; ++j) x_[j] = FROZEN ? fast_exp2(SA_(ks, j)) : fast_exp2(SA_(ks, j) + c2); \
        PSUM = ((x_[0] + x_[1]) + (x_[2] + x_[3])) + ((x_[4] + x_[5]) + (x_[6] + x_[7])); \
        u32x4 pw_; pw_.x = pk2(x_[0], x_[1]); pw_.y = pk2(x_[2], x_[3]); pw_.z = pk2(x_[4], x_[5]); pw_.w = pk2(x_[6], x_[7]); PF = __builtin_bit_cast(bf16x8, pw_); } while (0)
#define VLOAD(ks, DST) do { const LAS unsigned char* vp_ = Vb + (ks) * 32; \
        _Pragma("unroll") for (int nb = 0; nb < NB; ++nb) DST[nb] = *(const LAS bf16x8*)(vp_ + nb * 32 * VTP); } while (0)
#define PVMMA(SRC, PF) do { _Pragma("unroll") for (int nb = 0; nb < NB; ++nb) o[nb] = __builtin_amdgcn_mfma_f32_32x32x16_bf16(SRC[nb], PF, o[nb], 0, 0, 0); } while (0)
#define SBAR_() __builtin_amdgcn_sched_barrier(0)
        bf16x8 kf0[4], kf1[4], va[NB], vb[NB], pf0, pf1; float ps0, ps1, ps2, ps3;
        VLOAD(0, va);
        EXPCVT(0, pf0, ps0);
        SBAR_();
        VLOAD(1, vb); PVMMA(va, pf0); EXPCVT(1, pf1, ps1); SBAR_();
        VLOAD(2, va);
#pragma unroll
        for (int d0 = 0; d0 < 4; ++d0) { kf0[d0] = *(const LAS bf16x8*)(Kb + d0 * 32); kf1[d0] = *(const LAS bf16x8*)(Kb + 32 * KPB + d0 * 32); }
        PVMMA(vb, pf1); EXPCVT(2, pf0, ps2); SBAR_();
        {
            f32x16 z0, z1;
#pragma unroll
            for (int r = 0; r < 16; ++r) { z0[r] = 0.f; z1[r] = 0.f; }
#pragma unroll
            for (int d0 = 0; d0 < 4; ++d0) { z0 = __builtin_amdgcn_mfma_f32_32x32x16_bf16(kf0[d0], qf[d0], z0, 0, 0, 0); z1 = __builtin_amdgcn_mfma_f32_32x32x16_bf16(kf1[d0], qf[d0], z1, 0, 0, 0); }
            sB0 = z0; sB1 = z1;
        }
        EXPCVT(3, pf1, ps3);
        SBAR_();
        float tmr;
        VLOAD(3, vb); SBAR_();
        PVMMA(va, pf0); if constexpr (!FROZEN) ATT_MAX3(tmr); else tmr = 0.f; PVMMA(vb, pf1);
        const float ps = (ps0 + ps1) + (ps2 + ps3);
#undef SA_
#undef EXPCVT
#undef VLOAD
#undef PVMMA
#undef SBAR_
        l_run += ps;
        if (t + 1 < NT) { ATT_BIAS(t + 1, tmr); ATT_UPD(tmr); }
        asm volatile("s_waitcnt lgkmcnt(0)" ::: "memory"); __builtin_amdgcn_s_barrier(); asm volatile("" ::: "memory");
    }
    __syncthreads();
#undef ATT_QK
#undef ATT_BIAS
#undef ATT_UPD
#undef ATT_MAX3
    if constexpr (FROZEN) {
        const float lt_ = xhalf_sum(l_run); const bool bad_ = !(lt_ > 0x1p-60f && lt_ < 0x1p60f);
        LAS unsigned* flg_ = (LAS unsigned*)(lds + OFF_LUT + 4096);
        if (tid == 0) *flg_ = 0u;
        __syncthreads();
        if (__any(bad_) && lane == 0) *flg_ = 1u;
        __syncthreads();
        const bool redo_ = (*flg_ != 0u);
        __syncthreads();
        if (redo_) return false;
    }
    const float linv = 1.0f / xhalf_sum(l_run);
#pragma unroll
    for (int nb = 0; nb < NB; ++nb)
#pragma unroll
        for (int r = 0; r < 16; ++r) o[nb][r] *= linv;
    if constexpr (MODE == 1) {
        LAS float* ex = (LAS float*)lds;
        if (wid >= 4) {
#pragma unroll
            for (int nb = 0; nb < NB; ++nb)
#pragma unroll
                for (int r = 0; r < 16; ++r) ex[((wid - 4) * 64 + nb * 16 + r) * 64 + lane] = o[nb][r];
        }
        __syncthreads();
        if (wid < 4) {
            float ss = 0.f;
#pragma unroll
            for (int nb = 0; nb < NB; ++nb)
#pragma unroll
                for (int r = 0; r < 16; ++r) { const float a = o[nb][r] - lam * ex[(wid * 64 + nb * 16 + r) * 64 + lane]; o[nb][r] = a; ss += a * a; }
            ss = xhalf_sum(ss);
            const float rinv = (1.0f - lam_init) / sqrtf(ss * (1.0f / 128.0f) + 1e-6f);
            const float* sg = p.diff_subln_g + (size_t)l * 128;
            bf16_t* op = obuf + (size_t)qpos * 512 + ocol;
#pragma unroll
            for (int nb = 0; nb < NB; ++nb)
#pragma unroll
                for (int rq = 0; rq < 4; ++rq) {
                    const int dv = 32 * nb + 8 * rq + 4 * hi; const f32x4 gg = *(const f32x4*)(sg + dv);
                    u32x2 w; w.x = pk2(o[nb][4 * rq] * rinv * gg.x, o[nb][4 * rq + 1] * rinv * gg.y); w.y = pk2(o[nb][4 * rq + 2] * rinv * gg.z, o[nb][4 * rq + 3] * rinv * gg.w);
                    *(u32x2*)(op + dv) = w;
                }
        }
        __syncthreads();
    } else {
        bf16_t* op = obuf + (size_t)qpos * 512 + ocol;
#pragma unroll
        for (int nb = 0; nb < NB; ++nb)
#pragma unroll
            for (int rq = 0; rq < 4; ++rq) {
                const int dv = 32 * nb + 8 * rq + 4 * hi;
                u32x2 w; w.x = pk2(o[nb][4 * rq], o[nb][4 * rq + 1]); w.y = pk2(o[nb][4 * rq + 2], o[nb][4 * rq + 3]);
                *(u32x2*)(op + dv) = w;
            }
    }
    return true;
}

__device__ __forceinline__ void attn_phase(LAS unsigned char* lds, const Params& p, int l) {
    unsigned redo_mask = 0u; int ui_ = 0;
    for (int u = blockIdx.x; u < 512; u += gridDim.x, ++ui_) { const int x = u & 7; if (!attn_unit<1, true>(lds, p, l, x >> 1, (x & 1) * 64 + (u >> 3))) redo_mask |= 1u << (ui_ & 31); }
    asm volatile("" : "+s"(redo_mask) :: "memory");
    if (redo_mask) {
        ui_ = 0;
        for (int u = blockIdx.x; u < 512; u += gridDim.x, ++ui_) { int x = u & 7, j = u >> 3; asm volatile("" : "+s"(x), "+s"(j)); if (redo_mask & (1u << (ui_ & 31))) (void)attn_unit<1, false>(lds, p, l, x >> 1, (x & 1) * 64 + j); }
    }
    for (int u = blockIdx.x; u < 512; u += gridDim.x) (void)attn_unit<0>(lds, p, l, u & 7, u >> 3);
    for (int u = blockIdx.x; u < 512; u += gridDim.x) (void)attn_unit<2>(lds, p, l, u & 1, u >> 1);
}

#define XB_TMO      128
#define XB_XCNT(j)  (256  + 64 * (j))
#define XB_XSUB(j)  (1280 + 64 * (j))
#define XB_XGEN(j)  (2304 + 64 * (j))
#define XB_TOP      3328
#define XB_TOPGEN   3392
#define XCD_BAR_WORDS 3456
#define XB_SPIN_CAP (1u << 18)

__device__ __forceinline__ unsigned xb_ld(unsigned* p)              { return __hip_atomic_load(p, __ATOMIC_RELAXED, __HIP_MEMORY_SCOPE_AGENT); }
__device__ __forceinline__ unsigned xb_add(unsigned* p, unsigned v) { return __hip_atomic_fetch_add(p, v, __ATOMIC_RELAXED, __HIP_MEMORY_SCOPE_AGENT); }
__device__ __forceinline__ unsigned xb_xcc_id() { return (unsigned)__builtin_amdgcn_s_getreg((3 << 11) | 20) & 0xFu; }
#define XB_SPIN(cond, bar) do { unsigned _sp = 0; while (cond) { __builtin_amdgcn_s_sleep(1); \
    if ((++_sp & 255u) == 0u) { if (xb_ld(&(bar)[XB_TMO])) break; if (_sp > XB_SPIN_CAP) { atomicAdd(&(bar)[XB_TMO], 1u); break; } } } } while (0)

struct XcdBarrier {
    unsigned* bar; unsigned x;
    volatile LAS unsigned* st;
};

__device__ __forceinline__ XcdBarrier xcd_barrier_post(unsigned* bar, volatile LAS unsigned* st) {
    XcdBarrier b; b.bar = bar; b.x = xb_xcc_id(); b.st = st;
    if (threadIdx.x == 0) (void)xb_add(&bar[XB_XCNT(b.x)], 1u);
    return b;
}
__device__ __forceinline__ void xcd_barrier_complete(unsigned* bar, unsigned x, unsigned& nloc, unsigned& nx) {
    const unsigned G = gridDim.x * gridDim.y * gridDim.z;
    unsigned sum, cnt, mine, sp = 0u;
    for (;;) {
        sum = 0u; cnt = 0u; mine = 0u;
#pragma unroll
        for (unsigned j = 0; j < 16; ++j) { const unsigned c = xb_ld(&bar[XB_XCNT(j)]); sum += c; cnt += (c > 0u) ? 1u : 0u; mine = (j == x) ? c : mine; }
        if (sum == G) break;
        __builtin_amdgcn_s_sleep(1);
        if ((++sp & 255u) == 0u) { if (xb_ld(&bar[XB_TMO])) break; if (sp > XB_SPIN_CAP) { atomicAdd(&bar[XB_TMO], 1u); break; } }
    }
    nloc = mine > 0u ? mine : 1u; nx = cnt > 0u ? cnt : 1u;
}

__device__ __forceinline__ void xcd_barrier(const XcdBarrier& b) {
    asm volatile("s_waitcnt vmcnt(0)" ::: "memory");
    __syncthreads();
    if (threadIdx.x == 0) {
        unsigned* bar = b.bar;
        __builtin_amdgcn_s_waitcnt(0);
        unsigned nloc = b.st[0], nx = b.st[1];
        if (nloc == 0u) { xcd_barrier_complete(bar, b.x, nloc, nx); b.st[0] = nloc; b.st[1] = nx; }
        const unsigned old = xb_add(&bar[XB_XSUB(b.x)], 1u);
        const unsigned gen = old / nloc;
        if (old + 1u == (gen + 1u) * nloc) {
            __builtin_amdgcn_fence(__ATOMIC_RELEASE, "agent");
            asm volatile("s_waitcnt vmcnt(0)" ::: "memory");
            const unsigned og = xb_add(&bar[XB_TOP], 1u);
            const unsigned tg = og / nx;
            if (og + 1u == (tg + 1u) * nx) xb_add(&bar[XB_TOPGEN], 1u);
            else XB_SPIN(xb_ld(&bar[XB_TOPGEN]) == tg, bar);
            __builtin_amdgcn_fence(__ATOMIC_ACQUIRE, "agent");
            xb_add(&bar[XB_XGEN(b.x)], 1u);
            asm volatile("s_waitcnt vmcnt(0)" ::: "memory");
        } else {
            XB_SPIN(xb_ld(&bar[XB_XGEN(b.x)]) == gen, bar);
            __builtin_amdgcn_fence(__ATOMIC_ACQUIRE, "agent");
            asm volatile("s_waitcnt vmcnt(0)" ::: "memory");
        }
    }
    __syncthreads();
}

__global__ void __launch_bounds__(512) mk_fwd(Params p) {
    extern __shared__ __attribute__((aligned(16))) unsigned char lds_raw[];
    LAS unsigned char* lds = (LAS unsigned char*)lds_raw;
    cg::grid_group grid = cg::this_grid();
    volatile LAS unsigned* bst = (volatile LAS unsigned*)(lds + 131072);
    if (threadIdx.x < 4) bst[threadIdx.x] = 0u;
    __syncthreads();
    if (blockIdx.x == 0) { unsigned* bw = (unsigned*)(p.ws + B_BAR); for (int i = threadIdx.x; i < 4096; i += 512) bw[i] = 0u; }
    XcdBarrier bar; bar.bar = (unsigned*)(p.ws + B_BAR); bar.x = 0; bar.st = bst;
    bf16_t* XB = (bf16_t*)(p.ws + B_XB); bf16_t* PROJ = (bf16_t*)(p.ws + B_PROJ); bf16_t* G = (bf16_t*)(p.ws + B_G); bf16_t* Y = (bf16_t*)(p.ws + B_Y); bf16_t* MRG = (bf16_t*)(p.ws + B_MRG);
    float* SSQ = (float*)(p.ws + B_SSQ);
    bf16_t* HID = G;
    for (int step = p.step_lo; step < p.step_hi; ++step) {
        if (step == 0) {
            convert_layer(p, 0, lds, 0, CV_NITEMS, (int)blockIdx.x, (int)gridDim.x);
            prologue_rows(p.x, XB, SSQ);
        } else if (step == NSTEPS - 1) {
            final_norm(p.out, p.final_g);
        } else {
            const int l = (step - 1) / NSTEP_PER_LAYER, s = (step - 1) - l * NSTEP_PER_LAYER;
            bf16_t* W = (bf16_t*)(p.ws + B_W) + (size_t)(l & 1) * E_WTOT;
            if (s == 0 || s == 6) {
                pg8::Gemm g{XB, W + (s == 6 ? O_WGU1 : O_WGU0), S, 2 * DFF, DM}; pg8::StaticOrder So; So.init(S, 2 * DFF, gridDim.x, blockIdx.x);
                EpiSwiGLU E{HID, SSQ + (size_t)(l * 3 + (s == 6 ? 2 : 0)) * S * 16};
                pg8::gemm_phase<EpiSwiGLU, pg8::StaticOrder, true, true>(lds, g, So, E);
                {
                    const int full = (S / 256) * (2 * DFF / 256) % (int)gridDim.x;
                    if (l + 1 < NDEPTH && full != 0 && (int)blockIdx.x >= full)
                        convert_layer(p, l + 1, lds, s == 0 ? 0 : CV_CUT1, s == 0 ? CV_CUT1 : CV_CUT2, (int)blockIdx.x - full, (int)gridDim.x - full);
                    else if (l + 1 < NDEPTH && full == 0 && s == 6) convert_layer(p, l + 1, lds, 0, CV_CUT2, (int)blockIdx.x, (int)gridDim.x);
                }
            } else if (s == 1 || s == 7 || s == 5) {
                const bool ffn = (s != 5);
                pg8::Gemm g{ffn ? HID : MRG, W + (s == 1 ? O_WD0 : (s == 7 ? O_WD1 : O_WO)), S, DM, ffn ? DFF : DM}; pg8::StaticOrder So; So.init(S, DM, gridDim.x, blockIdx.x);
                const int nj = (s == 1) ? l * 3 + 1 : ((s == 5) ? l * 3 + 2 : l * 3 + 3);
                EpiResid E{(l == 0 && s == 1) ? p.x : p.out, p.out, XB, (nj < 12) ? SSQ + (size_t)nj * S * 16 : nullptr, ffn ? 0.5f : 1.0f};
                pg8::gemm_phase<EpiResid, pg8::StaticOrder, true, true>(lds, g, So, E);
            } else if (s == 2) {
                pg8::Gemm g{XB, W + O_WING, S, NPROJ + NGATE, DM}; pg8::StaticOrder So; So.init(S, NPROJ + NGATE, gridDim.x, blockIdx.x);
                EpiProjGate E{PROJ, G, p.b_gate + (size_t)l * NGATE, SSQ + (size_t)(l * 3 + 1) * S * 16, (bf16_t*)(p.ws + B_VT)};
                pg8::gemm_phase<EpiProjGate, pg8::StaticOrder, true, true>(lds, g, So, E);
                {
                    const int full = (S / 256) * ((NPROJ + NGATE) / 256) % (int)gridDim.x;
                    if (l + 1 < NDEPTH && full != 0 && (int)blockIdx.x >= full) convert_layer(p, l + 1, lds, CV_CUT2, CV_NITEMS, (int)blockIdx.x - full, (int)gridDim.x - full);
                    else if (l + 1 < NDEPTH && full == 0) convert_layer(p, l + 1, lds, CV_CUT2, CV_NITEMS, (int)blockIdx.x, (int)gridDim.x);
                }
            } else if (s == 3) {
                attn_phase(lds, p, l);
            } else if (s == 4) {
                for (int i = 0; i < 3; ++i) {
                    pg8::Gemm g{Y + (size_t)i * S * 512, W + O_WB + (size_t)i * E_WB, S, DM, 512}; pg8::StaticOrder So; So.init(S, DM, gridDim.x, blockIdx.x);
                    EpiBranch E{G, MRG, i * DM, i == 0};
                    pg8::gemm_phase<EpiBranch, pg8::StaticOrder, true, true>(lds, g, So, E);
                }
            }
        }
        if (step + 1 < p.step_hi) { if (step == p.step_lo) { grid.sync(); bar = xcd_barrier_post((unsigned*)(p.ws + B_BAR), bst); } else xcd_barrier(bar); }
    }
}

extern "C" void kernel_launch(void* const* d_in, const int* in_sizes, int n_in, void* d_out, int out_size, void* d_ws, size_t ws_size, hipStream_t stream) {
    static int grid = 0;
    if (grid == 0) {
        if (n_in != 16 || ws_size < B_END) { fprintf(stderr, "kernel_launch: unexpected n_in %d or ws_size %zu (< %zu)\n", n_in, ws_size, (size_t)B_END); grid = -1; return; }
        int dev = 0, cus = 0, per_cu = 0;
        hipGetDevice(&dev); hipDeviceGetAttribute(&cus, hipDeviceAttributeMultiprocessorCount, dev);
        if (hipFuncSetAttribute((const void*)mk_fwd, hipFuncAttributeMaxDynamicSharedMemorySize, LDS_BYTES) != hipSuccess) { fprintf(stderr, "kernel_launch: hipFuncSetAttribute failed\n"); grid = -1; return; }
        hipOccupancyMaxActiveBlocksPerMultiprocessor(&per_cu, (const void*)mk_fwd, 512, LDS_BYTES);
        if (per_cu < 1) { fprintf(stderr, "kernel_launch: occupancy query says %d blocks per CU\n", per_cu); per_cu = 1; }
        (void)hipGetLastError();
        grid = cus;
    }
    if (grid < 0) return;
    Params p{};
    p.x = (const float*)d_in[0]; p.w_in = (const float*)d_in[1]; p.w_branch = (const float*)d_in[2]; p.w_gate = (const float*)d_in[3]; p.b_gate = (const float*)d_in[4];
    p.w_o = (const float*)d_in[5]; p.norm_g = (const float*)d_in[6]; p.final_g = (const float*)d_in[7]; p.ffn_w_gate = (const float*)d_in[8]; p.ffn_w_up = (const float*)d_in[9];
    p.ffn_w_down = (const float*)d_in[10]; p.na_rpb = (const float*)d_in[11]; p.diff_lambda = (const float*)d_in[12]; p.diff_subln_g = (const float*)d_in[13]; p.gqa_sink = (const float*)d_in[14];
    p.rel_bias = (const float*)d_in[15]; p.out = (float*)d_out; p.ws = (unsigned char*)d_ws; p.step_lo = 0; p.step_hi = NSTEPS;
    void* args[] = {&p};
    hipError_t e = hipLaunchCooperativeKernel((const void*)mk_fwd, dim3(grid), dim3(512), args, LDS_BYTES, stream);
    if (e != hipSuccess) fprintf(stderr, "kernel_launch: cooperative launch failed: %s (grid %d)\n", hipGetErrorString(e), grid);
}
```

```cpp
#include <hip/hip_runtime.h>
#include <hip/hip_cooperative_groups.h>
#include <cstdio>
#include <cstdint>
namespace cg = cooperative_groups;
namespace pg8 {
#define PG8_LAS __attribute__((address_space(3)))
typedef unsigned short bf16_t;
typedef short bf16x8 __attribute__((ext_vector_type(8)));
typedef float f32x4 __attribute__((ext_vector_type(4)));
typedef unsigned u32x4 __attribute__((ext_vector_type(4)));
constexpr int BM = 256, BK = 64, HALF = 128, HTB = HALF * BK * 2  , STAGE_BYTES = 8 * HTB, NXCD = 8, WGM = 8;

__host__ __device__ __forceinline__ int lds_byte(int r, int c) { const int st = (r >> 4) * 2 + (c >> 5), rr = r & 15, cc = c & 31, ob = rr * 64 + cc * 2; return st * 1024 + (ob ^ (((ob >> 9) & 1) << 5)); }
__host__ __device__ __forceinline__ void stage_rc(int b, int& R, int& C) { const int st = b / 1024, sb = b % 1024, swz = sb ^ (((sb >> 9) & 1) << 5); R = (st >> 1) * 16 + swz / 64; C = (st & 1) * 32 + (swz % 64) / 2; }
__host__ __device__ __forceinline__ int perm32(int rho) { const int n = rho >> 4, i = rho & 15; return 8 * (i >> 2) + 4 * n + (i & 3); }

struct Unit { int pm, pn; };
struct Gemm { const bf16_t* A; const bf16_t* Bt; int M, N, K; };

struct StaticOrder {
    int nM, nN, nwg, G, c;
    __host__ __device__ void init(int M, int N, int G_, int c_) { nM = M / BM; nN = N / BM; nwg = nM * nN; G = G_; c = c_; }
    __host__ __device__ bool next(int i, Unit& u) const {
        const long L = (long)i * G + c; if (L >= nwg) return false;
        int wgid = (int)L; { const int q = nwg / NXCD, r = nwg % NXCD, xcd = wgid % NXCD, off = wgid / NXCD; wgid = (xcd < r ? xcd * (q + 1) : r * (q + 1) + (xcd - r) * q) + off; }
        const int nig = WGM * nN, gid = wgid / nig, fm = gid * WGM, gsz = (nM - fm) < WGM ? (nM - fm) : WGM;
        u.pm = fm + ((wgid % nig) % gsz); u.pn = (wgid % nig) / gsz; return true;
    }
    __device__ __forceinline__ void a_ready(const Unit&) const {}
    __device__ __forceinline__ void done(const Unit&) const {}
};

typedef float f32x2c __attribute__((ext_vector_type(2))); typedef __bf16 bf16x2c __attribute__((ext_vector_type(2)));
__device__ __forceinline__ unsigned cvt_pk_bf16(float lo, float hi) { f32x2c v = {lo, hi}; bf16x2c b = __builtin_convertvector(v, bf16x2c); return __builtin_bit_cast(unsigned, b); }
__device__ __forceinline__ int pg8_opaque_tid() { int t = threadIdx.x; asm volatile("" : "+v"(t)); return t; }
template <class Epi, class Sched, bool ALIGN_EPI = false, bool SP2 = false>
__device__ __forceinline__ void gemm_phase(PG8_LAS unsigned char* lds, const Gemm g, const Sched& S, const Epi& E) {
    const int tid = pg8_opaque_tid(), wid = __builtin_amdgcn_readfirstlane(tid >> 6), lane = tid & 63, wr = wid >> 2, wc = wid & 3, fr = lane & 15, fq = lane >> 4;
    const int K = g.K, nt = K / BK;
    unsigned voffA[2], voffB[2];
#pragma unroll
    for (int i = 0; i < 2; ++i) { int R, C; stage_rc(tid * 16 + i * 8192, R, C); const int Rb = Epi::PERM ? ((R & ~31) + perm32(R & 31)) : R;
        voffA[i] = (unsigned)(R * K + C) * 2u; voffB[i] = (unsigned)(Rb * K + C) * 2u; }
    const size_t kstep = (size_t)(BK * 2);
    const size_t hstep = (size_t)HALF * K * 2;
    const size_t tstep = 2 * hstep;
    const unsigned ldsw = (unsigned)wid * 1024u;
    const int aoff = lds_byte(wr * 64 + fr, fq * 8), boff = lds_byte(wc * 32 + fr, fq * 8);
#define PG8_SA(b, h) (((b) * 2 + (h)) * HTB)
#define PG8_SB(b, h) ((4 + (b) * 2 + (h)) * HTB)
#define PG8_STAGE(bufoff, gbase, voff) do { _Pragma("unroll") for (int _i = 0; _i < 2; ++_i) \
        __builtin_amdgcn_global_load_lds((const unsigned*)((const char*)(gbase) + (voff)[_i]), (PG8_LAS unsigned*)(lds + (bufoff) + ldsw + _i * 8192), 16, 0, 0); } while (0)
#define PG8_LDA(dst, b, h) do { _Pragma("unroll") for (int m = 0; m < 4; ++m) _Pragma("unroll") for (int k = 0; k < 2; ++k) dst[m][k] = *(const PG8_LAS bf16x8*)(lds + PG8_SA(b, h) + aoff + m * 2048 + k * 1024); } while (0)
#define PG8_LDB(dst, b, h) do { _Pragma("unroll") for (int n = 0; n < 2; ++n) _Pragma("unroll") for (int k = 0; k < 2; ++k) dst[n][k] = *(const PG8_LAS bf16x8*)(lds + PG8_SB(b, h) + boff + n * 2048 + k * 1024); } while (0)
#define PG8_MMA(ai, bj, At, Bt) do { __builtin_amdgcn_s_setprio(1); _Pragma("unroll") for (int m = 0; m < 4; ++m) _Pragma("unroll") for (int n = 0; n < 2; ++n) _Pragma("unroll") for (int k = 0; k < 2; ++k) \
        acc[ai][bj][m][n] = __builtin_amdgcn_mfma_f32_16x16x32_bf16(Bt[n][k], At[m][k], acc[ai][bj][m][n], 0, 0, 0); __builtin_amdgcn_s_setprio(0); } while (0)
#define PG8_WAIT_V(n) asm volatile("s_waitcnt vmcnt(" #n ")" ::: "memory")
#define PG8_WAIT_L(n) asm volatile("s_waitcnt lgkmcnt(" #n ")" ::: "memory")
#define PG8_BAR __builtin_amdgcn_s_barrier()
#define PG8_SCHED __builtin_amdgcn_sched_barrier(0)
    Unit cur, nxt; int ui = 0;
    if (!S.next(0, cur)) return;
    f32x4 acc[2][2][4][2];
#pragma unroll
    for (int a = 0; a < 2; ++a)
#pragma unroll
        for (int b = 0; b < 2; ++b)
#pragma unroll
            for (int m = 0; m < 4; ++m)
#pragma unroll
                for (int n = 0; n < 2; ++n) acc[a][b][m][n] = (f32x4){0.f, 0.f, 0.f, 0.f};
    bf16x8 At[4][2], B0[2][2], B1[2][2];
    const char* cA = (const char*)g.A + (size_t)cur.pm * tstep; const char* cB = (const char*)g.Bt + (size_t)cur.pn * tstep;
    S.a_ready(cur);
    if constexpr (SP2) {
        PG8_STAGE(PG8_SB(0, 0), cB, voffB); PG8_STAGE(PG8_SB(0, 1), cB + hstep, voffB); PG8_STAGE(PG8_SA(0, 0), cA, voffA); PG8_STAGE(PG8_SA(0, 1), cA + hstep, voffA);
        if (wr == 1) PG8_BAR;
        PG8_WAIT_V(2); PG8_BAR;
        PG8_STAGE(PG8_SB(1, 0), cB + kstep, voffB); PG8_STAGE(PG8_SA(1, 0), cA + kstep, voffA); PG8_STAGE(PG8_SB(1, 1), cB + hstep + kstep, voffB);
        PG8_WAIT_V(6); PG8_BAR;
    } else {
        PG8_STAGE(PG8_SB(0, 0), cB, voffB); PG8_STAGE(PG8_SA(0, 0), cA, voffA); PG8_STAGE(PG8_SB(0, 1), cB + hstep, voffB); PG8_STAGE(PG8_SA(0, 1), cA + hstep, voffA);
        if (wr == 1) PG8_BAR;
        PG8_WAIT_V(4); PG8_BAR;
        PG8_STAGE(PG8_SB(1, 0), cB + kstep, voffB); PG8_STAGE(PG8_SA(1, 0), cA + kstep, voffA); PG8_STAGE(PG8_SB(1, 1), cB + hstep + kstep, voffB);
        PG8_WAIT_V(6); PG8_BAR;
    }
    for (;;) {
        const bool has_next = S.next(ui + 1, nxt);
        const char* nA = has_next ? (const char*)g.A + (size_t)nxt.pm * tstep : cA; const char* nB = has_next ? (const char*)g.Bt + (size_t)nxt.pn * tstep : cB;
        for (int t = 0; t < nt; t += 2) {
            const bool last = (t == nt - 2);
            const char* a1 = cA + (size_t)(t + 1) * kstep;
            const char* a2 = last ? nA : cA + (size_t)(t + 2) * kstep; const char* b2 = last ? nB : cB + (size_t)(t + 2) * kstep;
            const char* a3 = a2 + kstep; const char* b3 = b2 + kstep;
            if (last && has_next) S.a_ready(nxt);
            if constexpr (SP2) {
            PG8_LDB(B0, 0, 0); PG8_LDB(B1, 0, 1); PG8_SCHED; PG8_LDA(At, 0, 0); PG8_STAGE(PG8_SA(1, 1), a1 + hstep, voffA);
            PG8_WAIT_V(8); PG8_WAIT_L(0); PG8_BAR; PG8_MMA(0, 0, At, B0); PG8_MMA(0, 1, At, B1); PG8_BAR; PG8_SCHED;
            PG8_LDA(At, 0, 1); PG8_STAGE(PG8_SB(0, 0), b2, voffB); PG8_STAGE(PG8_SB(0, 1), b2 + hstep, voffB); PG8_STAGE(PG8_SA(0, 0), a2, voffA);
            PG8_WAIT_V(8); PG8_WAIT_L(0); PG8_BAR; PG8_MMA(1, 0, At, B0); PG8_MMA(1, 1, At, B1); PG8_BAR; PG8_SCHED;
            PG8_LDB(B0, 1, 0); PG8_LDB(B1, 1, 1); PG8_SCHED; PG8_LDA(At, 1, 0); PG8_STAGE(PG8_SA(0, 1), a2 + hstep, voffA);
            PG8_WAIT_V(8); PG8_WAIT_L(0); PG8_BAR; PG8_MMA(0, 0, At, B0); PG8_MMA(0, 1, At, B1); PG8_BAR; PG8_SCHED;
            PG8_LDA(At, 1, 1); PG8_STAGE(PG8_SB(1, 0), b3, voffB); PG8_STAGE(PG8_SB(1, 1), b3 + hstep, voffB); PG8_STAGE(PG8_SA(1, 0), a3, voffA);
            PG8_WAIT_V(8); PG8_WAIT_L(0); PG8_BAR; PG8_MMA(1, 0, At, B0); PG8_MMA(1, 1, At, B1); PG8_BAR; PG8_SCHED;
            } else {
            PG8_LDB(B0, 0, 0); PG8_SCHED; PG8_LDA(At, 0, 0); PG8_STAGE(PG8_SA(1, 1), a1 + hstep, voffA);
            PG8_WAIT_L(8); PG8_BAR; PG8_WAIT_L(0); PG8_MMA(0, 0, At, B0); PG8_BAR; PG8_SCHED;
            PG8_LDB(B1, 0, 1); PG8_STAGE(PG8_SB(0, 0), b2, voffB);
            PG8_BAR; PG8_WAIT_L(0); PG8_MMA(0, 1, At, B1); PG8_BAR;
            PG8_LDA(At, 0, 1); PG8_STAGE(PG8_SA(0, 0), a2, voffA);
            PG8_BAR; PG8_WAIT_L(0); PG8_MMA(1, 0, At, B0); PG8_BAR; PG8_SCHED;
            PG8_STAGE(PG8_SB(0, 1), b2 + hstep, voffB);
            PG8_WAIT_V(6); PG8_BAR; PG8_MMA(1, 1, At, B1); PG8_BAR;
            PG8_LDB(B0, 1, 0); PG8_SCHED; PG8_LDA(At, 1, 0); PG8_STAGE(PG8_SA(0, 1), a2 + hstep, voffA);
            PG8_WAIT_L(8); PG8_BAR; PG8_WAIT_L(0); PG8_MMA(0, 0, At, B0); PG8_BAR; PG8_SCHED;
            PG8_LDB(B1, 1, 1); PG8_STAGE(PG8_SB(1, 0), b3, voffB);
            PG8_BAR; PG8_WAIT_L(0); PG8_MMA(0, 1, At, B1); PG8_BAR;
            PG8_LDA(At, 1, 1); PG8_STAGE(PG8_SA(1, 0), a3, voffA);
            PG8_BAR; PG8_WAIT_L(0); PG8_MMA(1, 0, At, B0); PG8_BAR; PG8_SCHED;
            PG8_STAGE(PG8_SB(1, 1), b3 + hstep, voffB);
            PG8_WAIT_V(6); PG8_BAR; PG8_MMA(1, 1, At, B1); PG8_BAR;
            }
        }
        if constexpr (ALIGN_EPI) { if (wr == 0) PG8_BAR; }
        if constexpr (!Epi::AFTER_DRAIN) { E(acc, cur, wr, wc, fr, fq); S.done(cur); }
        if (!has_next) break;
#pragma unroll
        for (int a = 0; a < 2; ++a)
#pragma unroll
            for (int b = 0; b < 2; ++b)
#pragma unroll
                for (int m = 0; m < 4; ++m)
#pragma unroll
                    for (int n = 0; n < 2; ++n) acc[a][b][m][n] = (f32x4){0.f, 0.f, 0.f, 0.f};
        cur = nxt; cA = nA; cB = nB; ++ui;
        if constexpr (ALIGN_EPI) { if (wr == 1) PG8_BAR; }
    }
    PG8_WAIT_V(0);
    if constexpr (!ALIGN_EPI) { if (wr == 0) PG8_BAR; }
    PG8_BAR;
    if constexpr (Epi::AFTER_DRAIN) { E.fused(acc, cur, wr, wc, fr, fq, lds, wid, lane); S.done(cur); }
#undef PG8_SA
#undef PG8_SB
#undef PG8_STAGE
#undef PG8_LDA
#undef PG8_LDB
#undef PG8_MMA
#undef PG8_WAIT_V
#undef PG8_WAIT_L
#undef PG8_BAR
#undef PG8_SCHED
}
}

#define LAS __attribute__((address_space(3)))
typedef unsigned short bf16_t;
typedef short bf16x8 __attribute__((ext_vector_type(8)));
typedef short s16x4 __attribute__((ext_vector_type(4)));
typedef float f32x4 __attribute__((ext_vector_type(4)));
typedef float f32x16 __attribute__((ext_vector_type(16)));
typedef unsigned u32x4 __attribute__((ext_vector_type(4)));
typedef unsigned u32x2 __attribute__((ext_vector_type(2)));

constexpr int S = 16384, DM = 1024, DFF = 2816, NPROJ = 3840, NGATE = 3072, NDEPTH = 4;
constexpr int NVT = 1152;
constexpr float LOG2E = 1.4426950408889634f;
constexpr float QSCALE = 0.125f * LOG2E;
constexpr float NEGBIG = -1e30f;
constexpr int NSTEP_PER_LAYER = 8, NSTEPS = 1 + NDEPTH * NSTEP_PER_LAYER + 1;

struct Params {
    const float *x, *w_in, *w_branch, *w_gate, *b_gate, *w_o, *norm_g, *final_g, *ffn_w_gate, *ffn_w_up, *ffn_w_down, *na_rpb, *diff_lambda, *diff_subln_g, *gqa_sink, *rel_bias;
    float* out; unsigned char* ws; int step_lo, step_hi;
};

constexpr size_t E_WGU = (size_t)2 * DFF * DM, E_WD = (size_t)DM * DFF, E_WING = (size_t)(NPROJ + NGATE) * DM, E_WB = (size_t)DM * 512, E_WO = (size_t)DM * DM;
constexpr size_t O_WGU0 = 0, O_WD0 = O_WGU0 + E_WGU, O_WING = O_WD0 + E_WD, O_WB = O_WING + E_WING, O_WO = O_WB + 3 * E_WB, O_WGU1 = O_WO + E_WO, O_WD1 = O_WGU1 + E_WGU, E_WTOT = O_WD1 + E_WD;
constexpr size_t B_W = 0, B_XB = B_W + 2 * E_WTOT * 2, B_PROJ = B_XB + (size_t)S * DM * 2, B_G = B_PROJ + (size_t)S * NPROJ * 2, B_Y = B_G + (size_t)S * NGATE * 2,
                 B_VT = B_Y + 3 * (size_t)S * 512 * 2, B_SSQ = B_VT + (size_t)NVT * S * 2, B_MRG = B_PROJ  , B_BAR = B_SSQ + (size_t)12 * S * 16 * 4, B_END = B_BAR + 16384;
constexpr int LDS_BYTES = 131072 + 1024;

__device__ __forceinline__ unsigned pk2(float lo, float hi) { return pg8::cvt_pk_bf16(lo, hi); }
__device__ __forceinline__ float bflo(unsigned w) { return __uint_as_float(w << 16); }
__device__ __forceinline__ float bfhi(unsigned w) { return __uint_as_float(w & 0xffff0000u); }
__device__ __forceinline__ float fast_exp2(float x) { return __builtin_amdgcn_exp2f(x); }
__device__ __forceinline__ float fast_rcp(float x) { return __builtin_amdgcn_rcpf(x); }
__device__ __forceinline__ float wave_sum(float v) {
#pragma unroll
    for (int o = 1; o < 64; o <<= 1) v += __shfl_xor(v, o);
    return v;
}
__device__ __forceinline__ float xhalf_sum(float v) { auto rr = __builtin_amdgcn_permlane32_swap(__float_as_uint(v), __float_as_uint(v), false, false); return __uint_as_float(rr[0]) + __uint_as_float(rr[1]); }
__device__ __forceinline__ float xhalf_max(float v) { auto rr = __builtin_amdgcn_permlane32_swap(__float_as_uint(v), __float_as_uint(v), false, false); return fmaxf(__uint_as_float(rr[0]), __uint_as_float(rr[1])); }

__device__ __forceinline__ float rstd_of(const float* ssq, int row) {
    const f32x4* q = (const f32x4*)(ssq + (size_t)row * 16); const f32x4 a = q[0], b = q[1], c = q[2], d = q[3];
    const float t = (((a.x + a.y) + (a.z + a.w)) + ((b.x + b.y) + (b.z + b.w))) + (((c.x + c.y) + (c.z + c.w)) + ((d.x + d.y) + (d.z + d.w)));
    return 1.0f / sqrtf(t * (1.0f / DM) + 1e-6f); }
struct EpiSwiGLU {
    static constexpr bool PERM = true, AFTER_DRAIN = false;
    bf16_t* O; const float* ssq;
    __device__ __forceinline__ void operator()(const pg8::f32x4 (&acc)[2][2][4][2], const pg8::Unit& u, int wr, int wc, int fr, int fq) const {
        const int row0 = u.pm * 256 + wr * 64 + fr, col0 = u.pn * 128 + wc * 32 + 8 * fq;
#pragma unroll
        for (int ai = 0; ai < 2; ++ai)
#pragma unroll
            for (int m = 0; m < 4; ++m) {
                const int row = row0 + ai * 128 + m * 16; const float rs = rstd_of(ssq, row);
                bf16_t* dst = O + (size_t)row * DFF + col0;
                float v[8];
#pragma unroll
                for (int n = 0; n < 2; ++n)
#pragma unroll
                    for (int j = 0; j < 4; ++j) { const float g = acc[ai][0][m][n][j] * rs, uu = acc[ai][1][m][n][j] * rs; v[n * 4 + j] = g * fast_rcp(1.0f + fast_exp2(-g * LOG2E)) * uu; }
                u32x4 w; w.x = pk2(v[0], v[1]); w.y = pk2(v[2], v[3]); w.z = pk2(v[4], v[5]); w.w = pk2(v[6], v[7]);
                *(u32x4*)dst = w;
            }
    }
};
struct EpiResid {
    static constexpr bool PERM = true, AFTER_DRAIN = false;
    const float* base; float* out; bf16_t* xb; float* ssq; float alpha;
    __device__ __forceinline__ void operator()(const pg8::f32x4 (&acc)[2][2][4][2], const pg8::Unit& u, int wr, int wc, int fr, int fq) const {
        const int row0 = u.pm * 256 + wr * 64 + fr, col0 = u.pn * 256 + wc * 32 + 8 * fq;
#pragma unroll
        for (int ai = 0; ai < 2; ++ai) {
            f32x4 bv[4][2][2];
#pragma unroll
            for (int m = 0; m < 4; ++m)
#pragma unroll
                for (int bj = 0; bj < 2; ++bj) { const size_t off = (size_t)(row0 + ai * 128 + m * 16) * DM + col0 + bj * 128; bv[m][bj][0] = *(const f32x4*)(base + off); bv[m][bj][1] = *(const f32x4*)(base + off + 4); }
#pragma unroll
            for (int m = 0; m < 4; ++m) {
                const int row = row0 + ai * 128 + m * 16; float ss = 0.f;
#pragma unroll
                for (int bj = 0; bj < 2; ++bj) {
                    const size_t off = (size_t)row * DM + col0 + bj * 128;
                    const f32x4 x0 = bv[m][bj][0] + acc[ai][bj][m][0] * alpha, x1 = bv[m][bj][1] + acc[ai][bj][m][1] * alpha;
                    *(f32x4*)(out + off) = x0; *(f32x4*)(out + off + 4) = x1;
                    u32x4 w; w.x = pk2(x0[0], x0[1]); w.y = pk2(x0[2], x0[3]); w.z = pk2(x1[0], x1[1]); w.w = pk2(x1[2], x1[3]);
                    *(u32x4*)(xb + off) = w;
                    ss += ((x0[0] * x0[0] + x0[1] * x0[1]) + (x0[2] * x0[2] + x0[3] * x0[3])) + ((x1[0] * x1[0] + x1[1] * x1[1]) + (x1[2] * x1[2] + x1[3] * x1[3]));
                }
                ss += __shfl_xor(ss, 16); ss += __shfl_xor(ss, 32);
                if (ssq && fq == 0) ssq[(size_t)row * 16 + u.pn * 4 + wc] = ss;
            }
            asm volatile("" ::: "memory");
        }
    }
};
struct EpiProjGate {
    static constexpr bool PERM = true, AFTER_DRAIN = false;
    bf16_t* proj; bf16_t* G; const float* bg; const float* ssq; bf16_t* vt;
    __device__ __forceinline__ void operator()(const pg8::f32x4 (&acc)[2][2][4][2], const pg8::Unit& u, int wr, int wc, int fr, int fq) const {
        const int row0 = u.pm * 256 + wr * 64 + fr;
        if (u.pn < 15) {
            const float sc = ((u.pn % 6) < 2) ? QSCALE : 1.0f;
            const int col0 = u.pn * 256 + wc * 32 + 8 * fq;
            const bool vt_all = (u.pn == 4) | (u.pn == 5) | (u.pn == 10) | (u.pn == 11), vt_half = (u.pn == 14);
            const int vrow0 = (u.pn <= 5 ? (u.pn - 4) * 256 : (u.pn <= 11 ? 512 + (u.pn - 10) * 256 : 1024 - 128)) + wc * 32 + 8 * fq;
#pragma unroll
            for (int ai = 0; ai < 2; ++ai)
#pragma unroll
                for (int m = 0; m < 4; ++m) {
                    const int row = row0 + ai * 128 + m * 16; const float rs = rstd_of(ssq, row) * sc;
#pragma unroll
                    for (int bj = 0; bj < 2; ++bj) {
                        const pg8::f32x4 v0 = acc[ai][bj][m][0] * rs, v1 = acc[ai][bj][m][1] * rs;
                        u32x4 w; w.x = pk2(v0[0], v0[1]); w.y = pk2(v0[2], v0[3]); w.z = pk2(v1[0], v1[1]); w.w = pk2(v1[2], v1[3]);
                        if (vt_all || (vt_half && bj == 1)) {
                            bf16_t* vp = vt + (size_t)(vrow0 + bj * 128) * S + row;
                            vp[0 * (size_t)S] = (bf16_t)(w.x & 0xffffu); vp[1 * (size_t)S] = (bf16_t)(w.x >> 16); vp[2 * (size_t)S] = (bf16_t)(w.y & 0xffffu); vp[3 * (size_t)S] = (bf16_t)(w.y >> 16);
                            vp[4 * (size_t)S] = (bf16_t)(w.z & 0xffffu); vp[5 * (size_t)S] = (bf16_t)(w.z >> 16); vp[6 * (size_t)S] = (bf16_t)(w.w & 0xffffu); vp[7 * (size_t)S] = (bf16_t)(w.w >> 16);
                        } else {
                            *(u32x4*)(proj + (size_t)row * NPROJ + col0 + bj * 128) = w;
                        }
                    }
                }
        } else {
            const int col0 = (u.pn - 15) * 256 + wc * 32 + 8 * fq;
            f32x4 bb[2][2];
#pragma unroll
            for (int bj = 0; bj < 2; ++bj) { bb[bj][0] = *(const f32x4*)(bg + col0 + bj * 128); bb[bj][1] = *(const f32x4*)(bg + col0 + bj * 128 + 4); }
#pragma unroll
            for (int ai = 0; ai < 2; ++ai)
#pragma unroll
                for (int m = 0; m < 4; ++m) {
                    const int row = row0 + ai * 128 + m * 16; const float rs = rstd_of(ssq, row);
#pragma unroll
                    for (int bj = 0; bj < 2; ++bj) {
                        float v[8];
#pragma unroll
                        for (int j = 0; j < 4; ++j) { v[j] = fast_rcp(1.0f + fast_exp2(-(acc[ai][bj][m][0][j] * rs + bb[bj][0][j]) * LOG2E)); v[4 + j] = fast_rcp(1.0f + fast_exp2(-(acc[ai][bj][m][1][j] * rs + bb[bj][1][j]) * LOG2E)); }
                        u32x4 w; w.x = pk2(v[0], v[1]); w.y = pk2(v[2], v[3]); w.z = pk2(v[4], v[5]); w.w = pk2(v[6], v[7]);
                        *(u32x4*)(G + (size_t)row * NGATE + col0 + bj * 128) = w;
                    }
                }
        }
    }
};
struct EpiBranch {
    static constexpr bool PERM = true, AFTER_DRAIN = false;
    const bf16_t* G; bf16_t* mrg; int coloff; bool first;
    __device__ __forceinline__ void operator()(const pg8::f32x4 (&acc)[2][2][4][2], const pg8::Unit& u, int wr, int wc, int fr, int fq) const {
        const int row0 = u.pm * 256 + wr * 64 + fr, col0 = u.pn * 256 + wc * 32 + 8 * fq;
#pragma unroll
        for (int ai = 0; ai < 2; ++ai) {
            u32x4 gv[4][2], ov[4][2];
#pragma unroll
            for (int m = 0; m < 4; ++m)
#pragma unroll
                for (int bj = 0; bj < 2; ++bj) {
                    const int row = row0 + ai * 128 + m * 16;
                    gv[m][bj] = *(const u32x4*)(G + (size_t)row * NGATE + coloff + col0 + bj * 128);
                    ov[m][bj] = (u32x4){0u, 0u, 0u, 0u}; if (!first) ov[m][bj] = *(const u32x4*)(mrg + (size_t)row * DM + col0 + bj * 128);
                }
#pragma unroll
            for (int m = 0; m < 4; ++m)
#pragma unroll
                for (int bj = 0; bj < 2; ++bj) {
                    const int row = row0 + ai * 128 + m * 16;
                    const u32x4 g = gv[m][bj], o = ov[m][bj]; const pg8::f32x4 a0 = acc[ai][bj][m][0], a1 = acc[ai][bj][m][1];
                    u32x4 w; w.x = pk2(bflo(o.x) + bflo(g.x) * a0[0], bfhi(o.x) + bfhi(g.x) * a0[1]); w.y = pk2(bflo(o.y) + bflo(g.y) * a0[2], bfhi(o.y) + bfhi(g.y) * a0[3]);
                    w.z = pk2(bflo(o.z) + bflo(g.z) * a1[0], bfhi(o.z) + bfhi(g.z) * a1[1]); w.w = pk2(bflo(o.w) + bflo(g.w) * a1[2], bfhi(o.w) + bfhi(g.w) * a1[3]);
                    *(u32x4*)(mrg + (size_t)row * DM + col0 + bj * 128) = w;
                }
            asm volatile("" ::: "memory");
        }
    }
};

__device__ __forceinline__ void transpose_tile(const float* src, int srcN, const float* gk, bf16_t* dst, int dstK, LAS float* scr, int lane) {
    float tv[32];
#pragma unroll
    for (int i = 0; i < 32; ++i) tv[i] = src[(size_t)(2 * i + (lane >> 5)) * srcN + (lane & 31)];
    if (gk) {
#pragma unroll
        for (int i = 0; i < 32; ++i) tv[i] *= gk[2 * i + (lane >> 5)];
    }
#pragma unroll
    for (int i = 0; i < 32; ++i) scr[(2 * i + (lane >> 5)) * 33 + (lane & 31)] = tv[i];
    asm volatile("s_waitcnt lgkmcnt(0)" ::: "memory");
    const int c = lane & 7;
#pragma unroll
    for (int j = 0; j < 4; ++j) {
        const int n = (lane >> 3) + 8 * j; const LAS float* s = scr + (8 * c) * 33 + n;
        u32x4 o; o.x = pk2(s[0 * 33], s[1 * 33]); o.y = pk2(s[2 * 33], s[3 * 33]); o.z = pk2(s[4 * 33], s[5 * 33]); o.w = pk2(s[6 * 33], s[7 * 33]);
        *(u32x4*)(dst + (size_t)n * dstK + 8 * c) = o;
    }
    asm volatile("s_waitcnt lgkmcnt(0)" ::: "memory");
}
constexpr int CV_I_GU = (2 * DFF / 32) * (DM / 64), CV_I_D = (DM / 32) * (DFF / 64), CV_I_ING = ((NPROJ + NGATE) / 32) * (DM / 64), CV_I_B = (DM / 32) * (512 / 64), CV_I_O = (DM / 32) * (DM / 64);
constexpr int CV_NITEMS = 2 * CV_I_GU + 2 * CV_I_D + CV_I_ING + 3 * CV_I_B + CV_I_O;
constexpr int CV_CUT1 = (CV_NITEMS * 2) / 5, CV_CUT2 = (CV_NITEMS * 4) / 5;
__device__ __forceinline__ void convert_layer(const Params& p, int l, LAS unsigned char* lds, int it_lo, int it_hi, int worker, int nworkers) {
    const int tid = pg8::pg8_opaque_tid(), lane = tid & 63, wid = __builtin_amdgcn_readfirstlane(tid >> 6);
    LAS float* scr = (LAS float*)(lds + wid * 8448);
    bf16_t* W = (bf16_t*)(p.ws + B_W) + (size_t)(l & 1) * E_WTOT;
    const float* ng = p.norm_g + (size_t)l * 3 * DM;
    constexpr int I_GU = CV_I_GU, I_D = CV_I_D, I_ING = CV_I_ING, I_B = CV_I_B;
    for (int it = it_lo + worker * 8 + wid; it < it_hi; it += nworkers * 8) {
        int r = it;
        if (r < 2 * I_GU) {
            const int f = r / I_GU; r -= f * I_GU; const int nb = r / (DM / 64), kb = r % (DM / 64), n0 = nb * 32, k0 = kb * 64;
            const int pn = n0 >> 8, w = n0 & 255; const float* src = ((w < 128) ? p.ffn_w_gate : p.ffn_w_up) + (size_t)(l * 2 + f) * DM * DFF;
            transpose_tile(src + (size_t)k0 * DFF + pn * 128 + (w & 127), DFF, ng + (f ? 2 : 0) * DM + k0, W + (f ? O_WGU1 : O_WGU0) + (size_t)n0 * DM + k0, DM, scr, lane); continue; }
        r -= 2 * I_GU;
        if (r < 2 * I_D) {
            const int f = r / I_D; r -= f * I_D; const int nb = r / (DFF / 64), kb = r % (DFF / 64), n0 = nb * 32, k0 = kb * 64;
            const float* src = p.ffn_w_down + (size_t)(l * 2 + f) * DFF * DM;
            transpose_tile(src + (size_t)k0 * DM + n0, DM, nullptr, W + (f ? O_WD1 : O_WD0) + (size_t)n0 * DFF + k0, DFF, scr, lane); continue; }
        r -= 2 * I_D;
        if (r < I_ING) {
            const int nb = r / (DM / 64), kb = r % (DM / 64), n0 = nb * 32, k0 = kb * 64;
            if (n0 < NPROJ) transpose_tile(p.w_in + (size_t)l * DM * NPROJ + (size_t)k0 * NPROJ + n0, NPROJ, ng + DM + k0, W + O_WING + (size_t)n0 * DM + k0, DM, scr, lane);
            else transpose_tile(p.w_gate + (size_t)l * DM * NGATE + (size_t)k0 * NGATE + (n0 - NPROJ), NGATE, ng + DM + k0, W + O_WING + (size_t)n0 * DM + k0, DM, scr, lane);
            continue; }
        r -= I_ING;
        if (r < 3 * I_B) {
            const int i = r / I_B; r -= i * I_B; const int nb = r / 8, kb = r % 8, n0 = nb * 32, k0 = kb * 64;
            transpose_tile(p.w_branch + (size_t)(l * 3 + i) * 512 * DM + (size_t)k0 * DM + n0, DM, nullptr, W + O_WB + (size_t)i * E_WB + (size_t)n0 * 512 + k0, 512, scr, lane); continue; }
        r -= 3 * I_B;
        {
            const int nb = r / (DM / 64), kb = r % (DM / 64), n0 = nb * 32, k0 = kb * 64;
            transpose_tile(p.w_o + (size_t)l * DM * DM + (size_t)k0 * DM + n0, DM, nullptr, W + O_WO + (size_t)n0 * DM + k0, DM, scr, lane); }
    }
}

__device__ __forceinline__ void prologue_rows(const float* x, bf16_t* xb, float* ssq) {
    const int tid = pg8::pg8_opaque_tid(), lane = tid & 63, wid = __builtin_amdgcn_readfirstlane(tid >> 6);
    const int gw = blockIdx.x * 8 + wid, NGW = gridDim.x * 8;
    for (int row0 = gw; row0 < S; row0 += 2 * NGW) {
        f32x4 v[2][4];
#pragma unroll
        for (int h = 0; h < 2; ++h)
#pragma unroll
            for (int j = 0; j < 4; ++j) v[h][j] = *((const f32x4*)(x + (size_t)(row0 + h * NGW) * DM) + lane + 64 * j);
#pragma unroll
        for (int h = 0; h < 2; ++h) {
            const int row = row0 + h * NGW; u32x2* o = (u32x2*)(xb + (size_t)row * DM) + lane; float ss = 0.f;
#pragma unroll
            for (int j = 0; j < 4; ++j) { const f32x4 t = v[h][j]; ss += (t.x * t.x + t.y * t.y) + (t.z * t.z + t.w * t.w); u32x2 w; w.x = pk2(t.x, t.y); w.y = pk2(t.z, t.w); o[64 * j] = w; }
            ss = wave_sum(ss);
            if (lane < 16) ssq[(size_t)row * 16 + lane] = (lane == 0) ? ss : 0.f;
        }
    }
}
__device__ __forceinline__ void final_norm(float* x, const float* g) {
    const int tid = pg8::pg8_opaque_tid(), lane = tid & 63, wid = __builtin_amdgcn_readfirstlane(tid >> 6);
    const int gw = blockIdx.x * 8 + wid, NGW = gridDim.x * 8;
    f32x4 gv[4];
#pragma unroll
    for (int j = 0; j < 4; ++j) gv[j] = *((const f32x4*)g + lane + 64 * j);
    for (int row0 = gw; row0 < S; row0 += 2 * NGW) {
        f32x4 v[2][4];
#pragma unroll
        for (int h = 0; h < 2; ++h)
#pragma unroll
            for (int j = 0; j < 4; ++j) v[h][j] = *((const f32x4*)(x + (size_t)(row0 + h * NGW) * DM) + lane + 64 * j);
#pragma unroll
        for (int h = 0; h < 2; ++h) {
            f32x4* xr = (f32x4*)(x + (size_t)(row0 + h * NGW) * DM) + lane; float ss = 0.f;
#pragma unroll
            for (int j = 0; j < 4; ++j) ss += (v[h][j].x * v[h][j].x + v[h][j].y * v[h][j].y) + (v[h][j].z * v[h][j].z + v[h][j].w * v[h][j].w);
            const float rstd = 1.0f / sqrtf(wave_sum(ss) * (1.0f / DM) + 1e-6f);
#pragma unroll
            for (int j = 0; j < 4; ++j) xr[64 * j] = v[h][j] * rstd * gv[j];
        }
    }
}

__device__ __forceinline__ float max2m(float a, float b) { return __builtin_amdgcn_fmed3f(a, b, __builtin_inff()); }
__device__ __forceinline__ float max3f(float a, float b, float c) { return max2m(max2m(a, b), c); }
__device__ __forceinline__ int crow(int r, int hi) { return (r & 3) + 8 * (r >> 2) + 4 * hi; }
__device__ __forceinline__ int t5_bucket(int rel) {
    const int n = rel < 0 ? -rel : rel; int b;
    if (n < 8) b = n; else if (n < 12) b = 8; else if (n < 16) b = 9; else if (n < 23) b = 10; else if (n < 32) b = 11; else if (n < 46) b = 12; else if (n < 64) b = 13; else if (n < 91) b = 14; else b = 15;
    return b + (rel > 0 ? 16 : 0);
}
typedef short v4i16_t __attribute__((ext_vector_type(4)));
__device__ __forceinline__ s16x4 tr_read(const LAS unsigned char* p) { return __builtin_bit_cast(s16x4, __builtin_amdgcn_ds_read_tr16_b64_v4i16((LAS v4i16_t*)p)); }

template <int MODE, bool FROZEN = false>
__device__ __forceinline__ bool attn_unit(LAS unsigned char* lds, const Params& p, int l, int ua, int ub) {
    constexpr int KW = (MODE == 1) ? 128 : 64, DV = (MODE == 1) ? 128 : 64, NB = DV / 32;
    constexpr int KPB = KW * 2 + 16, VTP = 144, KBUF = 64 * KPB, VBUF = DV * VTP;
    constexpr int OFF_K = 0, OFF_V = 2 * KBUF, OFF_LUT = 2 * KBUF + 2 * VBUF;
    constexpr int KCH = KW / 8, NKC = 64 * KCH / 512, NVC = DV * 8 / 512;
    const int tid = pg8::pg8_opaque_tid(), lane = tid & 63, wid = __builtin_amdgcn_readfirstlane(tid >> 6), r32 = lane & 31, hi = lane >> 5;
    const bf16_t* proj = (const bf16_t*)(p.ws + B_PROJ);
    const bf16_t* vtg = (const bf16_t*)(p.ws + B_VT);
    LAS float* lut = (LAS float*)(lds + OFF_LUT);

    int qtok0, qcol, kcol, vcol, kfo = 0, ocol = 0, kt0, NT, wt_lo = 0, wt_hi, lut_sel = 0, myrow = 0;
    bf16_t* obuf = (bf16_t*)(p.ws + B_Y) + (size_t)MODE * S * 512;
    float m_run = NEGBIG, l_run = 0.f, lam = 0.f, lam_init = 0.f;
    if constexpr (MODE == 0) {
        const int h = ua, R0 = ub * 4; myrow = R0 + (wid >> 1); qtok0 = myrow * 64 + (wid & 1) * 32;
        qcol = h * 64; kcol = 512 + h * 64; vcol = h * 64; ocol = h * 64;
        const int rs_first = min(max(R0 - 4, 0), 248), rs_last = min(max(R0 + 3 - 4, 0), 248), my_rs = min(max(myrow - 4, 0), 248);
        kt0 = rs_first * 64; NT = rs_last + 8 - rs_first; wt_lo = my_rs - rs_first; wt_hi = wt_lo + 8;
        for (int i = tid; i < 15 * 127; i += 512) { const int dr_ = i / 127, dc_ = min(max(i % 127 - 48, 0), 30); lut[i] = p.na_rpb[(size_t)(l * 8 + h) * 465 + dr_ * 31 + dc_] * LOG2E; }
    } else if constexpr (MODE == 1) {
        const int h = ua, qb = ub, c = wid >> 2; qtok0 = qb * 128 + (wid & 3) * 32;
        qcol = 1536 + h * 128 + c * 64; kcol = 2048 + h * 128; kfo = c * 64; vcol = 512 + h * 128; ocol = h * 128;
        kt0 = 0; NT = S / 64; wt_hi = NT;
        for (int i = tid; i < 449; i += 512) lut[i] = p.rel_bias[t5_bucket(i - 224) * 12 + h] * LOG2E;
        const float* lq = p.diff_lambda + (size_t)l * 256;
        const float s1 = wave_sum(lq[lane] * lq[64 + lane]), s2 = wave_sum(lq[128 + lane] * lq[192 + lane]);
        lam_init = 0.8f - 0.6f * expf(-0.3f * (float)l);
        lam = expf(s1) - expf(s2) + lam_init;
    } else {
        const int g = ua, qb = ub, hq = g * 4 + (wid >> 1); qtok0 = qb * 64 + (wid & 1) * 32; lut_sel = wid >> 1;
        qcol = 3072 + hq * 64; kcol = 3584 + g * 64; vcol = 1024 + g * 64; ocol = hq * 64;
        const int tlo = max(qb - 2, 0), thi = min(qb + 2, S / 64 - 1); kt0 = tlo * 64; NT = thi - tlo + 1; wt_hi = NT;
        for (int i = tid; i < 4 * 449; i += 512) { const int hh = i / 449, rel = i % 449 - 224; lut[i] = (rel >= -128 && rel <= 128) ? p.rel_bias[t5_bucket(rel) * 12 + 4 + g * 4 + hh] * LOG2E : NEGBIG; }
        m_run = p.gqa_sink[l * 8 + hq] * LOG2E; l_run = (hi == 0) ? 1.0f : 0.0f;
    }
    bf16x8 qf[4];
    { const bf16_t* qp = proj + (size_t)(qtok0 + r32) * NPROJ + qcol + 8 * hi;
#pragma unroll
      for (int d0 = 0; d0 < 4; ++d0) qf[d0] = *(const bf16x8*)(qp + 16 * d0); }
    f32x16 o[NB];
#pragma unroll
    for (int nb = 0; nb < NB; ++nb)
#pragma unroll
        for (int r = 0; r < 16; ++r) o[nb][r] = 0.f;

    u32x4 kr[NKC], vr[NVC];
    unsigned ksrc[NKC], vsrc[NVC]; int kdst[NKC], vdst[NVC];
    const bf16_t* kvbase = proj + (size_t)kt0 * NPROJ;
#pragma unroll
    for (int i = 0; i < NKC; ++i) { const int cid = tid + 512 * i, row = cid / KCH, ch = cid % KCH; ksrc[i] = (unsigned)(row * NPROJ + kcol + ch * 8); kdst[i] = OFF_K + row * KPB + ch * 16; }
#pragma unroll
    for (int i = 0; i < NVC; ++i) { const int cid = tid + 512 * i, row = cid >> 3, ch = cid & 7; vsrc[i] = (unsigned)((vcol + row) * S + ch * 8); vdst[i] = OFF_V + row * VTP + (ch >> 1) * 32 + (ch & 1) * 8; }
    const bf16_t* vtbase = vtg + kt0;
    {
        u32x4 k1[NKC];
#pragma unroll
        for (int i = 0; i < NKC; ++i) { kr[i] = *(const u32x4*)(kvbase + ksrc[i]); k1[i] = *(const u32x4*)(kvbase + (size_t)64 * NPROJ + ksrc[i]); }
#pragma unroll
        for (int i = 0; i < NVC; ++i) vr[i] = *(const u32x4*)(vtbase + vsrc[i]);
#pragma unroll
        for (int i = 0; i < NKC; ++i) { *(LAS u32x4*)(lds + kdst[i]) = kr[i]; *(LAS u32x4*)(lds + kdst[i] + KBUF) = k1[i]; }
#pragma unroll
        for (int i = 0; i < NVC; ++i) { *(LAS u32x2*)(lds + vdst[i]) = (u32x2){vr[i].x, vr[i].y}; *(LAS u32x2*)(lds + vdst[i] + 16) = (u32x2){vr[i].z, vr[i].w}; }
#pragma unroll
        for (int i = 0; i < NKC; ++i) kr[i] = *(const u32x4*)(kvbase + (size_t)2 * 64 * NPROJ + ksrc[i]);
#pragma unroll
        for (int i = 0; i < NVC; ++i) vr[i] = *(const u32x4*)(vtbase + 64 + vsrc[i]);
    }
    __syncthreads();

    const int qpos = qtok0 + r32;
    const int i16 = lane & 15, q4 = i16 >> 2, p4 = i16 & 3, blk = (lane >> 4) & 1;
    const int vlane_off = r32 * VTP + hi * 16;
    const int klane_off = r32 * KPB + (kfo + 8 * hi) * 2;

    f32x16 sB0, sB1; float cbB = 0.f; bool fastB = false;
#define ATT_QK(tt) do { const LAS unsigned char* Kb_ = lds + OFF_K + ((tt) & 1) * KBUF + klane_off; \
        f32x16 z0_, z1_; _Pragma("unroll") for (int r = 0; r < 16; ++r) { z0_[r] = 0.f; z1_[r] = 0.f; } \
        _Pragma("unroll") for (int d0 = 0; d0 < 4; ++d0) { \
            const bf16x8 k0_ = *(const LAS bf16x8*)(Kb_ + d0 * 32), k1_ = *(const LAS bf16x8*)(Kb_ + 32 * KPB + d0 * 32); \
            z0_ = __builtin_amdgcn_mfma_f32_32x32x16_bf16(k0_, qf[d0], z0_, 0, 0, 0); z1_ = __builtin_amdgcn_mfma_f32_32x32x16_bf16(k1_, qf[d0], z1_, 0, 0, 0); } \
        sB0 = z0_; sB1 = z1_; } while (0)
#define ATT_MAX3(dst) do { float tm_ = max3f(sB0[0], sB1[0], sB0[1]), tn_ = max3f(sB1[1], sB0[2], sB1[2]); \
        _Pragma("unroll") for (int r = 3; r < 15; r += 2) { tm_ = max3f(tm_, sB0[r], sB1[r]); tn_ = max3f(tn_, sB0[r + 1], sB1[r + 1]); } \
        tm_ = max3f(tm_, sB0[15], sB1[15]); dst = max3f(tm_, tn_, tn_); } while (0)
#define ATT_BIAS(tt, tmraw) do { const int ktok_ = kt0 + 64 * (tt); bool fast_ = false; cbB = 0.f; const float nm_ = FROZEN ? -m_run : 0.f; \
        if constexpr (MODE == 1) { if (ktok_ - (qtok0 + 31) >= 128) { cbB = cb_pos; fast_ = true; } else if (qtok0 - (ktok_ + 63) >= 128) { cbB = cb_neg; fast_ = true; } } \
        if (!fast_) { \
            if constexpr (MODE != 0) { \
                const LAS float* lp_ = lut + (ktok_ - qpos + 224 + 4 * hi + (MODE == 2 ? lut_sel * 449 : 0)); \
                _Pragma("unroll") for (int r = 0; r < 16; ++r) { const int cr_ = (r & 3) + 8 * (r >> 2); sB0[r] += lp_[cr_] + nm_; if ((r & 7) == 7) __builtin_amdgcn_sched_barrier(0); } \
                _Pragma("unroll") for (int r = 0; r < 16; ++r) { const int cr_ = (r & 3) + 8 * (r >> 2); sB1[r] += lp_[cr_ + 32] + nm_; if ((r & 7) == 7) __builtin_amdgcn_sched_barrier(0); } \
            } else { \
                if (!((tt) >= wt_lo && (tt) < wt_hi)) { _Pragma("unroll") for (int r = 0; r < 16; ++r) { sB0[r] = -INFINITY; sB1[r] = -INFINITY; } } \
                else { \
                    const int qc = (wid & 1) * 32 + r32, cs = min(max(qc - 8, 0), 48), dr = min(max((kt0 >> 6) + (tt) - myrow + 7, 0), 14); \
                    const LAS float* lp_ = lut + (dr * 127 + 63 - qc + 4 * hi); const int kb_ = 4 * hi - cs; \
                    _Pragma("unroll") for (int r = 0; r < 16; ++r) { const int cr_ = (r & 3) + 8 * (r >> 2); \
                        sB0[r] = ((unsigned)(kb_ + cr_) < 16u) ? sB0[r] + lp_[cr_] : NEGBIG; sB1[r] = ((unsigned)(kb_ + cr_ + 32) < 16u) ? sB1[r] + lp_[cr_ + 32] : NEGBIG; if ((r & 3) == 3) __builtin_amdgcn_sched_barrier(0); } \
                } } if constexpr (!FROZEN) ATT_MAX3(tmraw); } \
        fastB = fast_; \
    } while (0)
#define ATT_UPD(tmraw) do { \
        if constexpr (FROZEN) {              \
            if (fastB && __any(cbB != m_run)) { \
                const float f_ = fast_exp2(m_run - cbB); l_run *= f_; m_run = cbB; \
                _Pragma("unroll") for (int nb = 0; nb < NB; ++nb) _Pragma("unroll") for (int r = 0; r < 16; ++r) o[nb][r] *= f_; } \
        } else { \
            const float tm_ = xhalf_max(tmraw) + cbB; \
            if (__any(tm_ > m_run)) { \
                const float mn_ = fmaxf(m_run, tm_), f_ = fast_exp2(m_run - mn_); l_run *= f_; m_run = mn_; \
                _Pragma("unroll") for (int nb = 0; nb < NB; ++nb) _Pragma("unroll") for (int r = 0; r < 16; ++r) o[nb][r] *= f_; } } \
    } while (0)

    float cb_pos = 0.f, cb_neg = 0.f;
    if constexpr (MODE == 1) { cb_pos = lut[448]; cb_neg = lut[0]; }
    ATT_QK(0);
    if constexpr (FROZEN) m_run = cb_neg;
    { float tm0 = 0.f; if constexpr (!FROZEN) ATT_MAX3(tm0); ATT_BIAS(0, tm0); ATT_UPD(tm0); }
    __syncthreads();

    for (int t = 0; t < NT; ++t) {
        if (t + 2 < NT) {
#pragma unroll
            for (int i = 0; i < NKC; ++i) *(LAS u32x4*)(lds + kdst[i] + (t & 1) * KBUF) = kr[i];
        }
        if (t + 1 < NT) {
#pragma unroll
            for (int i = 0; i < NVC; ++i) { *(LAS u32x2*)(lds + vdst[i] + ((t + 1) & 1) * VBUF) = (u32x2){vr[i].x, vr[i].y}; *(LAS u32x2*)(lds + vdst[i] + ((t + 1) & 1) * VBUF + 16) = (u32x2){vr[i].z, vr[i].w}; }
        }
        {
            const size_t advk = (size_t)min(t + 3, NT - 1) * 64 * NPROJ, advv = (size_t)min(t + 2, NT - 1) * 64;
#pragma unroll
            for (int i = 0; i < NKC; ++i) kr[i] = *(const u32x4*)(kvbase + advk + ksrc[i]);
#pragma unroll
            for (int i = 0; i < NVC; ++i) vr[i] = *(const u32x4*)(vtbase + advv + vsrc[i]);
        }
        f32x16 sA0 = sB0, sA1 = sB1;
        const float c2 = cbB - m_run;
        const LAS unsigned char* Vb = lds + OFF_V + (t & 1) * VBUF + vlane_off;
        const LAS unsigned char* Kb = lds + OFF_K + ((t + 1) & 1) * KBUF + klane_off;
#define SA_(ks, j) ((((ks) >> 1) == 0) ? sA0[8 * ((ks) & 1) + (j)] : sA1[8 * ((ks) & 1) + (j)])
#define EXPCVT(ks, PF, PSUM) do { float x_[8]; _Pragma("unroll") for (int j = 0; j < 8; ++j) x_[j] = FROZEN ? fast_exp2(SA_(ks, j)) : fast_exp2(SA_(ks, j) + c2); \
        PSUM = ((x_[0] + x_[1]) + (x_[2] + x_[3])) + ((x_[4] + x_[5]) + (x_[6] + x_[7])); \
        u32x4 pw_; pw_.x = pk2(x_[0], x_[1]); pw_.y = pk2(x_[2], x_[3]); pw_.z = pk2(x_[4], x_[5]); pw_.w = pk2(x_[6], x_[7]); PF = __builtin_bit_cast(bf16x8, pw_); } while (0)
#define VLOAD(ks, DST) do { const LAS unsigned char* vp_ = Vb + (ks) * 32; \
        _Pragma("unroll") for (int nb = 0; nb < NB; ++nb) DST[nb] = *(const LAS bf16x8*)(vp_ + nb * 32 * VTP); } while (0)
#define PVMMA(SRC, PF) do { _Pragma("unroll") for (int nb = 0; nb < NB; ++nb) o[nb] = __builtin_amdgcn_mfma_f32_32x32x16_bf16(SRC[nb], PF, o[nb], 0, 0, 0); } while (0)
#define SBAR_() __builtin_amdgcn_sched_barrier(0)
        bf16x8 kf0[4], kf1[4], va[NB], vb[NB], pf0, pf1; float ps0, ps1, ps2, ps3;
        VLOAD(0, va);
        EXPCVT(0, pf0, ps0);
        SBAR_();
        VLOAD(1, vb); PVMMA(va, pf0); EXPCVT(1, pf1, ps1); SBAR_();
        VLOAD(2, va);
#pragma unroll
        for (int d0 = 0; d0 < 4; ++d0) { kf0[d0] = *(const LAS bf16x8*)(Kb + d0 * 32); kf1[d0] = *(const LAS bf16x8*)(Kb + 32 * KPB + d0 * 32); }
        PVMMA(vb, pf1); EXPCVT(2, pf0, ps2); SBAR_();
        {
            f32x16 z0, z1;
#pragma unroll
            for (int r = 0; r < 16; ++r) { z0[r] = 0.f; z1[r] = 0.f; }
#pragma unroll
            for (int d0 = 0; d0 < 4; ++d0) { z0 = __builtin_amdgcn_mfma_f32_32x32x16_bf16(kf0[d0], qf[d0], z0, 0, 0, 0); z1 = __builtin_amdgcn_mfma_f32_32x32x16_bf16(kf1[d0], qf[d0], z1, 0, 0, 0); }
            sB0 = z0; sB1 = z1;
        }
        EXPCVT(3, pf1, ps3);
        SBAR_();
        float tmr;
        VLOAD(3, vb); SBAR_();
        PVMMA(va, pf0); if constexpr (!FROZEN) ATT_MAX3(tmr); else tmr = 0.f; PVMMA(vb, pf1);
        const float ps = (ps0 + ps1) + (ps2 + ps3);
#undef SA_
#undef EXPCVT
#undef VLOAD
#undef PVMMA
#undef SBAR_
        l_run += ps;
        if (t + 1 < NT) { ATT_BIAS(t + 1, tmr); ATT_UPD(tmr); }
        asm volatile("s_waitcnt lgkmcnt(0)" ::: "memory"); __builtin_amdgcn_s_barrier(); asm volatile("" ::: "memory");
    }
    __syncthreads();
#undef ATT_QK
#undef ATT_BIAS
#undef ATT_UPD
#undef ATT_MAX3
    if constexpr (FROZEN) {
        const float lt_ = xhalf_sum(l_run); const bool bad_ = !(lt_ > 0x1p-60f && lt_ < 0x1p60f);
        LAS unsigned* flg_ = (LAS unsigned*)(lds + OFF_LUT + 4096);
        if (tid == 0) *flg_ = 0u;
        __syncthreads();
        if (__any(bad_) && lane == 0) *flg_ = 1u;
        __syncthreads();
        const bool redo_ = (*flg_ != 0u);
        __syncthreads();
        if (redo_) return false;
    }
    const float linv = 1.0f / xhalf_sum(l_run);
#pragma unroll
    for (int nb = 0; nb < NB; ++nb)
#pragma unroll
        for (int r = 0; r < 16; ++r) o[nb][r] *= linv;
    if constexpr (MODE == 1) {
        LAS float* ex = (LAS float*)lds;
        if (wid >= 4) {
#pragma unroll
            for (int nb = 0; nb < NB; ++nb)
#pragma unroll
                for (int r = 0; r < 16; ++r) ex[((wid - 4) * 64 + nb * 16 + r) * 64 + lane] = o[nb][r];
        }
        __syncthreads();
        if (wid < 4) {
            float ss = 0.f;
#pragma unroll
            for (int nb = 0; nb < NB; ++nb)
#pragma unroll
                for (int r = 0; r < 16; ++r) { const float a = o[nb][r] - lam * ex[(wid * 64 + nb * 16 + r) * 64 + lane]; o[nb][r] = a; ss += a * a; }
            ss = xhalf_sum(ss);
            const float rinv = (1.0f - lam_init) / sqrtf(ss * (1.0f / 128.0f) + 1e-6f);
            const float* sg = p.diff_subln_g + (size_t)l * 128;
            bf16_t* op = obuf + (size_t)qpos * 512 + ocol;
#pragma unroll
            for (int nb = 0; nb < NB; ++nb)
#pragma unroll
                for (int rq = 0; rq < 4; ++rq) {
                    const int dv = 32 * nb + 8 * rq + 4 * hi; const f32x4 gg = *(const f32x4*)(sg + dv);
                    u32x2 w; w.x = pk2(o[nb][4 * rq] * rinv * gg.x, o[nb][4 * rq + 1] * rinv * gg.y); w.y = pk2(o[nb][4 * rq + 2] * rinv * gg.z, o[nb][4 * rq + 3] * rinv * gg.w);
                    *(u32x2*)(op + dv) = w;
                }
        }
        __syncthreads();
    } else {
        bf16_t* op = obuf + (size_t)qpos * 512 + ocol;
#pragma unroll
        for (int nb = 0; nb < NB; ++nb)
#pragma unroll
            for (int rq = 0; rq < 4; ++rq) {
                const int dv = 32 * nb + 8 * rq + 4 * hi;
                u32x2 w; w.x = pk2(o[nb][4 * rq], o[nb][4 * rq + 1]); w.y = pk2(o[nb][4 * rq + 2], o[nb][4 * rq + 3]);
                *(u32x2*)(op + dv) = w;
            }
    }
    return true;
}

__device__ __forceinline__ void attn_phase(LAS unsigned char* lds, const Params& p, int l) {
    unsigned redo_mask = 0u; int ui_ = 0;
    for (int u = blockIdx.x; u < 512; u += gridDim.x, ++ui_) { const int x = u & 7; if (!attn_unit<1, true>(lds, p, l, x >> 1, (x & 1) * 64 + (u >> 3))) redo_mask |= 1u << (ui_ & 31); }
    asm volatile("" : "+s"(redo_mask) :: "memory");
    if (redo_mask) {
        ui_ = 0;
        for (int u = blockIdx.x; u < 512; u += gridDim.x, ++ui_) { int x = u & 7, j = u >> 3; asm volatile("" : "+s"(x), "+s"(j)); if (redo_mask & (1u << (ui_ & 31))) (void)attn_unit<1, false>(lds, p, l, x >> 1, (x & 1) * 64 + j); }
    }
    for (int u = blockIdx.x; u < 512; u += gridDim.x) (void)attn_unit<0>(lds, p, l, u & 7, u >> 3);
    for (int u = blockIdx.x; u < 512; u += gridDim.x) (void)attn_unit<2>(lds, p, l, u & 1, u >> 1);
}

#define XB_TMO      128
#define XB_XCNT(j)  (256  + 64 * (j))
#define XB_XSUB(j)  (1280 + 64 * (j))
#define XB_XGEN(j)  (2304 + 64 * (j))
#define XB_TOP      3328
#define XB_TOPGEN   3392
#define XCD_BAR_WORDS 3456
#define XB_SPIN_CAP (1u << 18)

__device__ __forceinline__ unsigned xb_ld(unsigned* p)              { return __hip_atomic_load(p, __ATOMIC_RELAXED, __HIP_MEMORY_SCOPE_AGENT); }
__device__ __forceinline__ unsigned xb_add(unsigned* p, unsigned v) { return __hip_atomic_fetch_add(p, v, __ATOMIC_RELAXED, __HIP_MEMORY_SCOPE_AGENT); }
__device__ __forceinline__ unsigned xb_xcc_id() { return (unsigned)__builtin_amdgcn_s_getreg((3 << 11) | 20) & 0xFu; }
#define XB_SPIN(cond, bar) do { unsigned _sp = 0; while (cond) { __builtin_amdgcn_s_sleep(1); \
    if ((++_sp & 255u) == 0u) { if (xb_ld(&(bar)[XB_TMO])) break; if (_sp > XB_SPIN_CAP) { atomicAdd(&(bar)[XB_TMO], 1u); break; } } } } while (0)

struct XcdBarrier {
    unsigned* bar; unsigned x;
    volatile LAS unsigned* st;
};

__device__ __forceinline__ XcdBarrier xcd_barrier_post(unsigned* bar, volatile LAS unsigned* st) {
    XcdBarrier b; b.bar = bar; b.x = xb_xcc_id(); b.st = st;
    if (threadIdx.x == 0) (void)xb_add(&bar[XB_XCNT(b.x)], 1u);
    return b;
}
__device__ __forceinline__ void xcd_barrier_complete(unsigned* bar, unsigned x, unsigned& nloc, unsigned& nx) {
    const unsigned G = gridDim.x * gridDim.y * gridDim.z;
    unsigned sum, cnt, mine, sp = 0u;
    for (;;) {
        sum = 0u; cnt = 0u; mine = 0u;
#pragma unroll
        for (unsigned j = 0; j < 16; ++j) { const unsigned c = xb_ld(&bar[XB_XCNT(j)]); sum += c; cnt += (c > 0u) ? 1u : 0u; mine = (j == x) ? c : mine; }
        if (sum == G) break;
        __builtin_amdgcn_s_sleep(1);
        if ((++sp & 255u) == 0u) { if (xb_ld(&bar[XB_TMO])) break; if (sp > XB_SPIN_CAP) { atomicAdd(&bar[XB_TMO], 1u); break; } }
    }
    nloc = mine > 0u ? mine : 1u; nx = cnt > 0u ? cnt : 1u;
}

__device__ __forceinline__ void xcd_barrier(const XcdBarrier& b) {
    asm volatile("s_waitcnt vmcnt(0)" ::: "memory");
    __syncthreads();
    if (threadIdx.x == 0) {
        unsigned* bar = b.bar;
        __builtin_amdgcn_s_waitcnt(0);
        unsigned nloc = b.st[0], nx = b.st[1];
        if (nloc == 0u) { xcd_barrier_complete(bar, b.x, nloc, nx); b.st[0] = nloc; b.st[1] = nx; }
        const unsigned old = xb_add(&bar[XB_XSUB(b.x)], 1u);
        const unsigned gen = old / nloc;
        if (old + 1u == (gen + 1u) * nloc) {
            __builtin_amdgcn_fence(__ATOMIC_RELEASE, "agent");
            asm volatile("s_waitcnt vmcnt(0)" ::: "memory");
            const unsigned og = xb_add(&bar[XB_TOP], 1u);
            const unsigned tg = og / nx;
            if (og + 1u == (tg + 1u) * nx) xb_add(&bar[XB_TOPGEN], 1u);
            else XB_SPIN(xb_ld(&bar[XB_TOPGEN]) == tg, bar);
            __builtin_amdgcn_fence(__ATOMIC_ACQUIRE, "agent");
            xb_add(&bar[XB_XGEN(b.x)], 1u);
            asm volatile("s_waitcnt vmcnt(0)" ::: "memory");
        } else {
            XB_SPIN(xb_ld(&bar[XB_XGEN(b.x)]) == gen, bar);
            __builtin_amdgcn_fence(__ATOMIC_ACQUIRE, "agent");
            asm volatile("s_waitcnt vmcnt(0)" ::: "memory");
        }
    }
    __syncthreads();
}

__global__ void __launch_bounds__(512) mk_fwd(Params p) {
    extern __shared__ __attribute__((aligned(16))) unsigned char lds_raw[];
    LAS unsigned char* lds = (LAS unsigned char*)lds_raw;
    cg::grid_group grid = cg::this_grid();
    volatile LAS unsigned* bst = (volatile LAS unsigned*)(lds + 131072);
    if (threadIdx.x < 4) bst[threadIdx.x] = 0u;
    __syncthreads();
    const XcdBarrier bar = xcd_barrier_post((unsigned*)(p.ws + B_BAR), bst);
    bf16_t* XB = (bf16_t*)(p.ws + B_XB); bf16_t* PROJ = (bf16_t*)(p.ws + B_PROJ); bf16_t* G = (bf16_t*)(p.ws + B_G); bf16_t* Y = (bf16_t*)(p.ws + B_Y); bf16_t* MRG = (bf16_t*)(p.ws + B_MRG);
    float* SSQ = (float*)(p.ws + B_SSQ);
    bf16_t* HID = G;
    for (int step = p.step_lo; step < p.step_hi; ++step) {
        if (step == 0) {
            convert_layer(p, 0, lds, 0, CV_NITEMS, (int)blockIdx.x, (int)gridDim.x);
            prologue_rows(p.x, XB, SSQ);
        } else if (step == NSTEPS - 1) {
            final_norm(p.out, p.final_g);
        } else {
            const int l = (step - 1) / NSTEP_PER_LAYER, s = (step - 1) - l * NSTEP_PER_LAYER;
            bf16_t* W = (bf16_t*)(p.ws + B_W) + (size_t)(l & 1) * E_WTOT;
            if (s == 0 || s == 6) {
                pg8::Gemm g{XB, W + (s == 6 ? O_WGU1 : O_WGU0), S, 2 * DFF, DM}; pg8::StaticOrder So; So.init(S, 2 * DFF, gridDim.x, blockIdx.x);
                EpiSwiGLU E{HID, SSQ + (size_t)(l * 3 + (s == 6 ? 2 : 0)) * S * 16};
                pg8::gemm_phase<EpiSwiGLU, pg8::StaticOrder, true, true>(lds, g, So, E);
                {
                    const int full = (S / 256) * (2 * DFF / 256) % (int)gridDim.x;
                    if (l + 1 < NDEPTH && full != 0 && (int)blockIdx.x >= full)
                        convert_layer(p, l + 1, lds, s == 0 ? 0 : CV_CUT1, s == 0 ? CV_CUT1 : CV_CUT2, (int)blockIdx.x - full, (int)gridDim.x - full);
                    else if (l + 1 < NDEPTH && full == 0 && s == 6) convert_layer(p, l + 1, lds, 0, CV_CUT2, (int)blockIdx.x, (int)gridDim.x);
                }
            } else if (s == 1 || s == 7 || s == 5) {
                const bool ffn = (s != 5);
                pg8::Gemm g{ffn ? HID : MRG, W + (s == 1 ? O_WD0 : (s == 7 ? O_WD1 : O_WO)), S, DM, ffn ? DFF : DM}; pg8::StaticOrder So; So.init(S, DM, gridDim.x, blockIdx.x);
                const int nj = (s == 1) ? l * 3 + 1 : ((s == 5) ? l * 3 + 2 : l * 3 + 3);
                EpiResid E{(l == 0 && s == 1) ? p.x : p.out, p.out, XB, (nj < 12) ? SSQ + (size_t)nj * S * 16 : nullptr, ffn ? 0.5f : 1.0f};
                pg8::gemm_phase<EpiResid, pg8::StaticOrder, true, true>(lds, g, So, E);
            } else if (s == 2) {
                pg8::Gemm g{XB, W + O_WING, S, NPROJ + NGATE, DM}; pg8::StaticOrder So; So.init(S, NPROJ + NGATE, gridDim.x, blockIdx.x);
                EpiProjGate E{PROJ, G, p.b_gate + (size_t)l * NGATE, SSQ + (size_t)(l * 3 + 1) * S * 16, (bf16_t*)(p.ws + B_VT)};
                pg8::gemm_phase<EpiProjGate, pg8::StaticOrder, true, true>(lds, g, So, E);
                {
                    const int full = (S / 256) * ((NPROJ + NGATE) / 256) % (int)gridDim.x;
                    if (l + 1 < NDEPTH && full != 0 && (int)blockIdx.x >= full) convert_layer(p, l + 1, lds, CV_CUT2, CV_NITEMS, (int)blockIdx.x - full, (int)gridDim.x - full);
                    else if (l + 1 < NDEPTH && full == 0) convert_layer(p, l + 1, lds, CV_CUT2, CV_NITEMS, (int)blockIdx.x, (int)gridDim.x);
                }
            } else if (s == 3) {
                attn_phase(lds, p, l);
            } else if (s == 4) {
                for (int i = 0; i < 3; ++i) {
                    pg8::Gemm g{Y + (size_t)i * S * 512, W + O_WB + (size_t)i * E_WB, S, DM, 512}; pg8::StaticOrder So; So.init(S, DM, gridDim.x, blockIdx.x);
                    EpiBranch E{G, MRG, i * DM, i == 0};
                    pg8::gemm_phase<EpiBranch, pg8::StaticOrder, true, true>(lds, g, So, E);
                }
            }
        }
        if (step + 1 < p.step_hi) { if (p.step_hi < 0) grid.sync(); else xcd_barrier(bar); }
    }
}

extern "C" void kernel_launch(void* const* d_in, const int* in_sizes, int n_in, void* d_out, int out_size, void* d_ws, size_t ws_size, hipStream_t stream) {
    static int grid = 0;
    if (grid == 0) {
        if (n_in != 16 || ws_size < B_END) { fprintf(stderr, "kernel_launch: unexpected n_in %d or ws_size %zu (< %zu)\n", n_in, ws_size, (size_t)B_END); grid = -1; return; }
        int dev = 0, cus = 0, per_cu = 0;
        hipGetDevice(&dev); hipDeviceGetAttribute(&cus, hipDeviceAttributeMultiprocessorCount, dev);
        if (hipFuncSetAttribute((const void*)mk_fwd, hipFuncAttributeMaxDynamicSharedMemorySize, LDS_BYTES) != hipSuccess) { fprintf(stderr, "kernel_launch: hipFuncSetAttribute failed\n"); grid = -1; return; }
        hipOccupancyMaxActiveBlocksPerMultiprocessor(&per_cu, (const void*)mk_fwd, 512, LDS_BYTES);
        if (per_cu < 1) { fprintf(stderr, "kernel_launch: occupancy query says %d blocks per CU\n", per_cu); per_cu = 1; }
        (void)hipGetLastError();
        grid = cus;
    }
    if (grid < 0) return;
    Params p{};
    p.x = (const float*)d_in[0]; p.w_in = (const float*)d_in[1]; p.w_branch = (const float*)d_in[2]; p.w_gate = (const float*)d_in[3]; p.b_gate = (const float*)d_in[4];
    p.w_o = (const float*)d_in[5]; p.norm_g = (const float*)d_in[6]; p.final_g = (const float*)d_in[7]; p.ffn_w_gate = (const float*)d_in[8]; p.ffn_w_up = (const float*)d_in[9];
    p.ffn_w_down = (const float*)d_in[10]; p.na_rpb = (const float*)d_in[11]; p.diff_lambda = (const float*)d_in[12]; p.diff_subln_g = (const float*)d_in[13]; p.gqa_sink = (const float*)d_in[14];
    p.rel_bias = (const float*)d_in[15]; p.out = (float*)d_out; p.ws = (unsigned char*)d_ws; p.step_lo = 0; p.step_hi = NSTEPS;
    if (hipMemsetAsync((char*)d_ws + B_BAR, 0, 16384, stream) != hipSuccess) { fprintf(stderr, "kernel_launch: hipMemsetAsync failed\n"); return; }
    void* args[] = {&p};
    hipError_t e = hipLaunchCooperativeKernel((const void*)mk_fwd, dim3(grid), dim3(512), args, LDS_BYTES, stream);
    if (e != hipSuccess) fprintf(stderr, "kernel_launch: cooperative launch failed: %s (grid %d)\n", hipGetErrorString(e), grid);
}
```

```cpp
#include <hip/hip_runtime.h>
#include <hip/hip_cooperative_groups.h>
#include <cstdio>
#include <cstdint>
namespace cg = cooperative_groups;
namespace pg8 {
#define PG8_LAS __attribute__((address_space(3)))
typedef unsigned short bf16_t;
typedef short bf16x8 __attribute__((ext_vector_type(8)));
typedef float f32x4 __attribute__((ext_vector_type(4)));
typedef unsigned u32x4 __attribute__((ext_vector_type(4)));
constexpr int BM = 256, BK = 64, HALF = 128, HTB = HALF * BK * 2  , STAGE_BYTES = 8 * HTB, NXCD = 8, WGM = 8;

__host__ __device__ __forceinline__ int lds_byte(int r, int c) { const int st = (r >> 4) * 2 + (c >> 5), rr = r & 15, cc = c & 31, ob = rr * 64 + cc * 2; return st * 1024 + (ob ^ (((ob >> 9) & 1) << 5)); }
__host__ __device__ __forceinline__ void stage_rc(int b, int& R, int& C) { const int st = b / 1024, sb = b % 1024, swz = sb ^ (((sb >> 9) & 1) << 5); R = (st >> 1) * 16 + swz / 64; C = (st & 1) * 32 + (swz % 64) / 2; }
__host__ __device__ __forceinline__ int perm32(int rho) { const int n = rho >> 4, i = rho & 15; return 8 * (i >> 2) + 4 * n + (i & 3); }

struct Unit { int pm, pn; };
struct Gemm { const bf16_t* A; const bf16_t* Bt; int M, N, K; };

struct StaticOrder {
    int nM, nN, nwg, G, c;
    __host__ __device__ void init(int M, int N, int G_, int c_) { nM = M / BM; nN = N / BM; nwg = nM * nN; G = G_; c = c_; }
    __host__ __device__ bool next(int i, Unit& u) const {
        const long L = (long)i * G + c; if (L >= nwg) return false;
        int wgid = (int)L; { const int q = nwg / NXCD, r = nwg % NXCD, xcd = wgid % NXCD, off = wgid / NXCD; wgid = (xcd < r ? xcd * (q + 1) : r * (q + 1) + (xcd - r) * q) + off; }
        const int nig = WGM * nN, gid = wgid / nig, fm = gid * WGM, gsz = (nM - fm) < WGM ? (nM - fm) : WGM;
        u.pm = fm + ((wgid % nig) % gsz); u.pn = (wgid % nig) / gsz; return true;
    }
    __device__ __forceinline__ void a_ready(const Unit&) const {}
    __device__ __forceinline__ void done(const Unit&) const {}
};

typedef float f32x2c __attribute__((ext_vector_type(2))); typedef __bf16 bf16x2c __attribute__((ext_vector_type(2)));
__device__ __forceinline__ unsigned cvt_pk_bf16(float lo, float hi) { f32x2c v = {lo, hi}; bf16x2c b = __builtin_convertvector(v, bf16x2c); return __builtin_bit_cast(unsigned, b); }
__device__ __forceinline__ int pg8_opaque_tid() { int t = threadIdx.x; asm volatile("" : "+v"(t)); return t; }
template <class Epi, class Sched, bool ALIGN_EPI = false, bool SP2 = false>
__device__ __forceinline__ void gemm_phase(PG8_LAS unsigned char* lds, const Gemm g, const Sched& S, const Epi& E) {
    const int tid = pg8_opaque_tid(), wid = __builtin_amdgcn_readfirstlane(tid >> 6), lane = tid & 63, wr = wid >> 2, wc = wid & 3, fr = lane & 15, fq = lane >> 4;
    const int K = g.K, nt = K / BK;
    unsigned voffA[2], voffB[2];
#pragma unroll
    for (int i = 0; i < 2; ++i) { int R, C; stage_rc(tid * 16 + i * 8192, R, C); const int Rb = Epi::PERM ? ((R & ~31) + perm32(R & 31)) : R;
        voffA[i] = (unsigned)(R * K + C) * 2u; voffB[i] = (unsigned)(Rb * K + C) * 2u; }
    const size_t kstep = (size_t)(BK * 2);
    const size_t hstep = (size_t)HALF * K * 2;
    const size_t tstep = 2 * hstep;
    const unsigned ldsw = (unsigned)wid * 1024u;
    const int aoff = lds_byte(wr * 64 + fr, fq * 8), boff = lds_byte(wc * 32 + fr, fq * 8);
#define PG8_SA(b, h) (((b) * 2 + (h)) * HTB)
#define PG8_SB(b, h) ((4 + (b) * 2 + (h)) * HTB)
#define PG8_STAGE(bufoff, gbase, voff) do { _Pragma("unroll") for (int _i = 0; _i < 2; ++_i) \
        __builtin_amdgcn_global_load_lds((const unsigned*)((const char*)(gbase) + (voff)[_i]), (PG8_LAS unsigned*)(lds + (bufoff) + ldsw + _i * 8192), 16, 0, 0); } while (0)
#define PG8_LDA(dst, b, h) do { _Pragma("unroll") for (int m = 0; m < 4; ++m) _Pragma("unroll") for (int k = 0; k < 2; ++k) dst[m][k] = *(const PG8_LAS bf16x8*)(lds + PG8_SA(b, h) + aoff + m * 2048 + k * 1024); } while (0)
#define PG8_LDB(dst, b, h) do { _Pragma("unroll") for (int n = 0; n < 2; ++n) _Pragma("unroll") for (int k = 0; k < 2; ++k) dst[n][k] = *(const PG8_LAS bf16x8*)(lds + PG8_SB(b, h) + boff + n * 2048 + k * 1024); } while (0)
#define PG8_MMA(ai, bj, At, Bt) do { __builtin_amdgcn_s_setprio(1); _Pragma("unroll") for (int m = 0; m < 4; ++m) _Pragma("unroll") for (int n = 0; n < 2; ++n) _Pragma("unroll") for (int k = 0; k < 2; ++k) \
        acc[ai][bj][m][n] = __builtin_amdgcn_mfma_f32_16x16x32_bf16(Bt[n][k], At[m][k], acc[ai][bj][m][n], 0, 0, 0); __builtin_amdgcn_s_setprio(0); } while (0)
#define PG8_WAIT_V(n) asm volatile("s_waitcnt vmcnt(" #n ")" ::: "memory")
#define PG8_WAIT_L(n) asm volatile("s_waitcnt lgkmcnt(" #n ")" ::: "memory")
#define PG8_BAR __builtin_amdgcn_s_barrier()
#define PG8_SCHED __builtin_amdgcn_sched_barrier(0)
    Unit cur, nxt; int ui = 0;
    if (!S.next(0, cur)) return;
    f32x4 acc[2][2][4][2];
#pragma unroll
    for (int a = 0; a < 2; ++a)
#pragma unroll
        for (int b = 0; b < 2; ++b)
#pragma unroll
            for (int m = 0; m < 4; ++m)
#pragma unroll
                for (int n = 0; n < 2; ++n) acc[a][b][m][n] = (f32x4){0.f, 0.f, 0.f, 0.f};
    bf16x8 At[4][2], B0[2][2], B1[2][2];
    const char* cA = (const char*)g.A + (size_t)cur.pm * tstep; const char* cB = (const char*)g.Bt + (size_t)cur.pn * tstep;
    S.a_ready(cur);
    if constexpr (SP2) {
        PG8_STAGE(PG8_SB(0, 0), cB, voffB); PG8_STAGE(PG8_SB(0, 1), cB + hstep, voffB); PG8_STAGE(PG8_SA(0, 0), cA, voffA); PG8_STAGE(PG8_SA(0, 1), cA + hstep, voffA);
        if (wr == 1) PG8_BAR;
        PG8_WAIT_V(2); PG8_BAR;
        PG8_STAGE(PG8_SB(1, 0), cB + kstep, voffB); PG8_STAGE(PG8_SA(1, 0), cA + kstep, voffA); PG8_STAGE(PG8_SB(1, 1), cB + hstep + kstep, voffB);
        PG8_WAIT_V(6); PG8_BAR;
    } else {
        PG8_STAGE(PG8_SB(0, 0), cB, voffB); PG8_STAGE(PG8_SA(0, 0), cA, voffA); PG8_STAGE(PG8_SB(0, 1), cB + hstep, voffB); PG8_STAGE(PG8_SA(0, 1), cA + hstep, voffA);
        if (wr == 1) PG8_BAR;
        PG8_WAIT_V(4); PG8_BAR;
        PG8_STAGE(PG8_SB(1, 0), cB + kstep, voffB); PG8_STAGE(PG8_SA(1, 0), cA + kstep, voffA); PG8_STAGE(PG8_SB(1, 1), cB + hstep + kstep, voffB);
        PG8_WAIT_V(6); PG8_BAR;
    }
    for (;;) {
        const bool has_next = S.next(ui + 1, nxt);
        const char* nA = has_next ? (const char*)g.A + (size_t)nxt.pm * tstep : cA; const char* nB = has_next ? (const char*)g.Bt + (size_t)nxt.pn * tstep : cB;
        for (int t = 0; t < nt; t += 2) {
            const bool last = (t == nt - 2);
            const char* a1 = cA + (size_t)(t + 1) * kstep;
            const char* a2 = last ? nA : cA + (size_t)(t + 2) * kstep; const char* b2 = last ? nB : cB + (size_t)(t + 2) * kstep;
            const char* a3 = a2 + kstep; const char* b3 = b2 + kstep;
            if (last && has_next) S.a_ready(nxt);
            if constexpr (SP2) {
            PG8_LDB(B0, 0, 0); PG8_LDB(B1, 0, 1); PG8_SCHED; PG8_LDA(At, 0, 0); PG8_STAGE(PG8_SA(1, 1), a1 + hstep, voffA);
            PG8_WAIT_V(8); PG8_WAIT_L(0); PG8_BAR; PG8_MMA(0, 0, At, B0); PG8_MMA(0, 1, At, B1); PG8_BAR; PG8_SCHED;
            PG8_LDA(At, 0, 1); PG8_STAGE(PG8_SB(0, 0), b2, voffB); PG8_STAGE(PG8_SB(0, 1), b2 + hstep, voffB); PG8_STAGE(PG8_SA(0, 0), a2, voffA);
            PG8_WAIT_V(8); PG8_WAIT_L(0); PG8_BAR; PG8_MMA(1, 0, At, B0); PG8_MMA(1, 1, At, B1); PG8_BAR; PG8_SCHED;
            PG8_LDB(B0, 1, 0); PG8_LDB(B1, 1, 1); PG8_SCHED; PG8_LDA(At, 1, 0); PG8_STAGE(PG8_SA(0, 1), a2 + hstep, voffA);
            PG8_WAIT_V(8); PG8_WAIT_L(0); PG8_BAR; PG8_MMA(0, 0, At, B0); PG8_MMA(0, 1, At, B1); PG8_BAR; PG8_SCHED;
            PG8_LDA(At, 1, 1); PG8_STAGE(PG8_SB(1, 0), b3, voffB); PG8_STAGE(PG8_SB(1, 1), b3 + hstep, voffB); PG8_STAGE(PG8_SA(1, 0), a3, voffA);
            PG8_WAIT_V(8); PG8_WAIT_L(0); PG8_BAR; PG8_MMA(1, 0, At, B0); PG8_MMA(1, 1, At, B1); PG8_BAR; PG8_SCHED;
            } else {
            PG8_LDB(B0, 0, 0); PG8_SCHED; PG8_LDA(At, 0, 0); PG8_STAGE(PG8_SA(1, 1), a1 + hstep, voffA);
            PG8_WAIT_L(8); PG8_BAR; PG8_WAIT_L(0); PG8_MMA(0, 0, At, B0); PG8_BAR; PG8_SCHED;
            PG8_LDB(B1, 0, 1); PG8_STAGE(PG8_SB(0, 0), b2, voffB);
            PG8_BAR; PG8_WAIT_L(0); PG8_MMA(0, 1, At, B1); PG8_BAR;
            PG8_LDA(At, 0, 1); PG8_STAGE(PG8_SA(0, 0), a2, voffA);
            PG8_BAR; PG8_WAIT_L(0); PG8_MMA(1, 0, At, B0); PG8_BAR; PG8_SCHED;
            PG8_STAGE(PG8_SB(0, 1), b2 + hstep, voffB);
            PG8_WAIT_V(6); PG8_BAR; PG8_MMA(1, 1, At, B1); PG8_BAR;
            PG8_LDB(B0, 1, 0); PG8_SCHED; PG8_LDA(At, 1, 0); PG8_STAGE(PG8_SA(0, 1), a2 + hstep, voffA);
            PG8_WAIT_L(8); PG8_BAR; PG8_WAIT_L(0); PG8_MMA(0, 0, At, B0); PG8_BAR; PG8_SCHED;
            PG8_LDB(B1, 1, 1); PG8_STAGE(PG8_SB(1, 0), b3, voffB);
            PG8_BAR; PG8_WAIT_L(0); PG8_MMA(0, 1, At, B1); PG8_BAR;
            PG8_LDA(At, 1, 1); PG8_STAGE(PG8_SA(1, 0), a3, voffA);
            PG8_BAR; PG8_WAIT_L(0); PG8_MMA(1, 0, At, B0); PG8_BAR; PG8_SCHED;
            PG8_STAGE(PG8_SB(1, 1), b3 + hstep, voffB);
            PG8_WAIT_V(6); PG8_BAR; PG8_MMA(1, 1, At, B1); PG8_BAR;
            }
        }
        if constexpr (ALIGN_EPI) { if (wr == 0) PG8_BAR; }
        if constexpr (!Epi::AFTER_DRAIN) { E(acc, cur, wr, wc, fr, fq); S.done(cur); }
        if (!has_next) break;
#pragma unroll
        for (int a = 0; a < 2; ++a)
#pragma unroll
            for (int b = 0; b < 2; ++b)
#pragma unroll
                for (int m = 0; m < 4; ++m)
#pragma unroll
                    for (int n = 0; n < 2; ++n) acc[a][b][m][n] = (f32x4){0.f, 0.f, 0.f, 0.f};
        cur = nxt; cA = nA; cB = nB; ++ui;
        if constexpr (ALIGN_EPI) { if (wr == 1) PG8_BAR; }
    }
    PG8_WAIT_V(0);
    if constexpr (!ALIGN_EPI) { if (wr == 0) PG8_BAR; }
    PG8_BAR;
    if constexpr (Epi::AFTER_DRAIN) { E.fused(acc, cur, wr, wc, fr, fq, lds, wid, lane); S.done(cur); }
#undef PG8_SA
#undef PG8_SB
#undef PG8_STAGE
#undef PG8_LDA
#undef PG8_LDB
#undef PG8_MMA
#undef PG8_WAIT_V
#undef PG8_WAIT_L
#undef PG8_BAR
#undef PG8_SCHED
}
}

#define LAS __attribute__((address_space(3)))
typedef unsigned short bf16_t;
typedef short bf16x8 __attribute__((ext_vector_type(8)));
typedef short s16x4 __attribute__((ext_vector_type(4)));
typedef float f32x4 __attribute__((ext_vector_type(4)));
typedef float f32x16 __attribute__((ext_vector_type(16)));
typedef unsigned u32x4 __attribute__((ext_vector_type(4)));
typedef unsigned u32x2 __attribute__((ext_vector_type(2)));

constexpr int S = 16384, DM = 1024, DFF = 2816, NPROJ = 3840, NGATE = 3072, NDEPTH = 4;
constexpr int NVT = 1152;
constexpr float LOG2E = 1.4426950408889634f;
constexpr float QSCALE = 0.125f * LOG2E;
constexpr float NEGBIG = -1e30f;
constexpr int NSTEP_PER_LAYER = 8, NSTEPS = 1 + NDEPTH * NSTEP_PER_LAYER + 1;

struct Params {
    const float *x, *w_in, *w_branch, *w_gate, *b_gate, *w_o, *norm_g, *final_g, *ffn_w_gate, *ffn_w_up, *ffn_w_down, *na_rpb, *diff_lambda, *diff_subln_g, *gqa_sink, *rel_bias;
    float* out; unsigned char* ws; int step_lo, step_hi;
};

constexpr size_t E_WGU = (size_t)2 * DFF * DM, E_WD = (size_t)DM * DFF, E_WING = (size_t)(NPROJ + NGATE) * DM, E_WB = (size_t)DM * 512, E_WO = (size_t)DM * DM;
constexpr size_t O_WGU0 = 0, O_WD0 = O_WGU0 + E_WGU, O_WING = O_WD0 + E_WD, O_WB = O_WING + E_WING, O_WO = O_WB + 3 * E_WB, O_WGU1 = O_WO + E_WO, O_WD1 = O_WGU1 + E_WGU, E_WTOT = O_WD1 + E_WD;
constexpr size_t B_W = 0, B_XB = B_W + 2 * E_WTOT * 2, B_PROJ = B_XB + (size_t)S * DM * 2, B_G = B_PROJ + (size_t)S * NPROJ * 2, B_Y = B_G + (size_t)S * NGATE * 2,
                 B_VT = B_Y + 3 * (size_t)S * 512 * 2, B_SSQ = B_VT + (size_t)NVT * S * 2, B_MRG = B_PROJ  , B_BAR = B_SSQ + (size_t)12 * S * 16 * 4, B_END = B_BAR + 16384;
constexpr int LDS_BYTES = 131072 + 1024;

__device__ __forceinline__ unsigned pk2(float lo, float hi) { return pg8::cvt_pk_bf16(lo, hi); }
__device__ __forceinline__ float bflo(unsigned w) { return __uint_as_float(w << 16); }
__device__ __forceinline__ float bfhi(unsigned w) { return __uint_as_float(w & 0xffff0000u); }
__device__ __forceinline__ float fast_exp2(float x) { return __builtin_amdgcn_exp2f(x); }
__device__ __forceinline__ float fast_rcp(float x) { return __builtin_amdgcn_rcpf(x); }
__device__ __forceinline__ float wave_sum(float v) {
#pragma unroll
    for (int o = 1; o < 64; o <<= 1) v += __shfl_xor(v, o);
    return v;
}
__device__ __forceinline__ float xhalf_sum(float v) { auto rr = __builtin_amdgcn_permlane32_swap(__float_as_uint(v), __float_as_uint(v), false, false); return __uint_as_float(rr[0]) + __uint_as_float(rr[1]); }
__device__ __forceinline__ float xhalf_max(float v) { auto rr = __builtin_amdgcn_permlane32_swap(__float_as_uint(v), __float_as_uint(v), false, false); return fmaxf(__uint_as_float(rr[0]), __uint_as_float(rr[1])); }

__device__ __forceinline__ float rstd_of(const float* ssq, int row) {
    const f32x4* q = (const f32x4*)(ssq + (size_t)row * 16); const f32x4 a = q[0], b = q[1], c = q[2], d = q[3];
    const float t = (((a.x + a.y) + (a.z + a.w)) + ((b.x + b.y) + (b.z + b.w))) + (((c.x + c.y) + (c.z + c.w)) + ((d.x + d.y) + (d.z + d.w)));
    return 1.0f / sqrtf(t * (1.0f / DM) + 1e-6f); }
struct EpiSwiGLU {
    static constexpr bool PERM = true, AFTER_DRAIN = false;
    bf16_t* O; const float* ssq;
    __device__ __forceinline__ void operator()(const pg8::f32x4 (&acc)[2][2][4][2], const pg8::Unit& u, int wr, int wc, int fr, int fq) const {
        const int row0 = u.pm * 256 + wr * 64 + fr, col0 = u.pn * 128 + wc * 32 + 8 * fq;
#pragma unroll
        for (int ai = 0; ai < 2; ++ai)
#pragma unroll
            for (int m = 0; m < 4; ++m) {
                const int row = row0 + ai * 128 + m * 16; const float rs = rstd_of(ssq, row);
                bf16_t* dst = O + (size_t)row * DFF + col0;
                float v[8];
#pragma unroll
                for (int n = 0; n < 2; ++n)
#pragma unroll
                    for (int j = 0; j < 4; ++j) { const float g = acc[ai][0][m][n][j] * rs, uu = acc[ai][1][m][n][j] * rs; v[n * 4 + j] = g * fast_rcp(1.0f + fast_exp2(-g * LOG2E)) * uu; }
                u32x4 w; w.x = pk2(v[0], v[1]); w.y = pk2(v[2], v[3]); w.z = pk2(v[4], v[5]); w.w = pk2(v[6], v[7]);
                *(u32x4*)dst = w;
            }
    }
};
struct EpiResid {
    static constexpr bool PERM = true, AFTER_DRAIN = false;
    const float* base; float* out; bf16_t* xb; float* ssq; float alpha;
    __device__ __forceinline__ void operator()(const pg8::f32x4 (&acc)[2][2][4][2], const pg8::Unit& u, int wr, int wc, int fr, int fq) const {
        const int row0 = u.pm * 256 + wr * 64 + fr, col0 = u.pn * 256 + wc * 32 + 8 * fq;
#pragma unroll
        for (int ai = 0; ai < 2; ++ai) {
            f32x4 bv[4][2][2];
#pragma unroll
            for (int m = 0; m < 4; ++m)
#pragma unroll
                for (int bj = 0; bj < 2; ++bj) { const size_t off = (size_t)(row0 + ai * 128 + m * 16) * DM + col0 + bj * 128; bv[m][bj][0] = *(const f32x4*)(base + off); bv[m][bj][1] = *(const f32x4*)(base + off + 4); }
#pragma unroll
            for (int m = 0; m < 4; ++m) {
                const int row = row0 + ai * 128 + m * 16; float ss = 0.f;
#pragma unroll
                for (int bj = 0; bj < 2; ++bj) {
                    const size_t off = (size_t)row * DM + col0 + bj * 128;
                    const f32x4 x0 = bv[m][bj][0] + acc[ai][bj][m][0] * alpha, x1 = bv[m][bj][1] + acc[ai][bj][m][1] * alpha;
                    *(f32x4*)(out + off) = x0; *(f32x4*)(out + off + 4) = x1;
                    u32x4 w; w.x = pk2(x0[0], x0[1]); w.y = pk2(x0[2], x0[3]); w.z = pk2(x1[0], x1[1]); w.w = pk2(x1[2], x1[3]);
                    *(u32x4*)(xb + off) = w;
                    ss += ((x0[0] * x0[0] + x0[1] * x0[1]) + (x0[2] * x0[2] + x0[3] * x0[3])) + ((x1[0] * x1[0] + x1[1] * x1[1]) + (x1[2] * x1[2] + x1[3] * x1[3]));
                }
                ss += __shfl_xor(ss, 16); ss += __shfl_xor(ss, 32);
                if (ssq && fq == 0) ssq[(size_t)row * 16 + u.pn * 4 + wc] = ss;
            }
            asm volatile("" ::: "memory");
        }
    }
};
struct EpiProjGate {
    static constexpr bool PERM = true, AFTER_DRAIN = false;
    bf16_t* proj; bf16_t* G; const float* bg; const float* ssq; bf16_t* vt;
    __device__ __forceinline__ void operator()(const pg8::f32x4 (&acc)[2][2][4][2], const pg8::Unit& u, int wr, int wc, int fr, int fq) const {
        const int row0 = u.pm * 256 + wr * 64 + fr;
        if (u.pn < 15) {
            const float sc = ((u.pn % 6) < 2) ? QSCALE : 1.0f;
            const int col0 = u.pn * 256 + wc * 32 + 8 * fq;
            const bool vt_all = (u.pn == 4) | (u.pn == 5) | (u.pn == 10) | (u.pn == 11), vt_half = (u.pn == 14);
            const int vrow0 = (u.pn <= 5 ? (u.pn - 4) * 256 : (u.pn <= 11 ? 512 + (u.pn - 10) * 256 : 1024 - 128)) + wc * 32 + 8 * fq;
#pragma unroll
            for (int ai = 0; ai < 2; ++ai)
#pragma unroll
                for (int m = 0; m < 4; ++m) {
                    const int row = row0 + ai * 128 + m * 16; const float rs = rstd_of(ssq, row) * sc;
#pragma unroll
                    for (int bj = 0; bj < 2; ++bj) {
                        const pg8::f32x4 v0 = acc[ai][bj][m][0] * rs, v1 = acc[ai][bj][m][1] * rs;
                        u32x4 w; w.x = pk2(v0[0], v0[1]); w.y = pk2(v0[2], v0[3]); w.z = pk2(v1[0], v1[1]); w.w = pk2(v1[2], v1[3]);
                        if (vt_all || (vt_half && bj == 1)) {
                            bf16_t* vp = vt + (size_t)(vrow0 + bj * 128) * S + row;
                            vp[0 * (size_t)S] = (bf16_t)(w.x & 0xffffu); vp[1 * (size_t)S] = (bf16_t)(w.x >> 16); vp[2 * (size_t)S] = (bf16_t)(w.y & 0xffffu); vp[3 * (size_t)S] = (bf16_t)(w.y >> 16);
                            vp[4 * (size_t)S] = (bf16_t)(w.z & 0xffffu); vp[5 * (size_t)S] = (bf16_t)(w.z >> 16); vp[6 * (size_t)S] = (bf16_t)(w.w & 0xffffu); vp[7 * (size_t)S] = (bf16_t)(w.w >> 16);
                        } else {
                            *(u32x4*)(proj + (size_t)row * NPROJ + col0 + bj * 128) = w;
                        }
                    }
                }
        } else {
            const int col0 = (u.pn - 15) * 256 + wc * 32 + 8 * fq;
            f32x4 bb[2][2];
#pragma unroll
            for (int bj = 0; bj < 2; ++bj) { bb[bj][0] = *(const f32x4*)(bg + col0 + bj * 128); bb[bj][1] = *(const f32x4*)(bg + col0 + bj * 128 + 4); }
#pragma unroll
            for (int ai = 0; ai < 2; ++ai)
#pragma unroll
                for (int m = 0; m < 4; ++m) {
                    const int row = row0 + ai * 128 + m * 16; const float rs = rstd_of(ssq, row);
#pragma unroll
                    for (int bj = 0; bj < 2; ++bj) {
                        float v[8];
#pragma unroll
                        for (int j = 0; j < 4; ++j) { v[j] = fast_rcp(1.0f + fast_exp2(-(acc[ai][bj][m][0][j] * rs + bb[bj][0][j]) * LOG2E)); v[4 + j] = fast_rcp(1.0f + fast_exp2(-(acc[ai][bj][m][1][j] * rs + bb[bj][1][j]) * LOG2E)); }
                        u32x4 w; w.x = pk2(v[0], v[1]); w.y = pk2(v[2], v[3]); w.z = pk2(v[4], v[5]); w.w = pk2(v[6], v[7]);
                        *(u32x4*)(G + (size_t)row * NGATE + col0 + bj * 128) = w;
                    }
                }
        }
    }
};
struct EpiBranch {
    static constexpr bool PERM = true, AFTER_DRAIN = false;
    const bf16_t* G; bf16_t* mrg; int coloff; bool first;
    __device__ __forceinline__ void operator()(const pg8::f32x4 (&acc)[2][2][4][2], const pg8::Unit& u, int wr, int wc, int fr, int fq) const {
        const int row0 = u.pm * 256 + wr * 64 + fr, col0 = u.pn * 256 + wc * 32 + 8 * fq;
#pragma unroll
        for (int ai = 0; ai < 2; ++ai) {
            u32x4 gv[4][2], ov[4][2];
#pragma unroll
            for (int m = 0; m < 4; ++m)
#pragma unroll
                for (int bj = 0; bj < 2; ++bj) {
                    const int row = row0 + ai * 128 + m * 16;
                    gv[m][bj] = *(const u32x4*)(G + (size_t)row * NGATE + coloff + col0 + bj * 128);
                    ov[m][bj] = (u32x4){0u, 0u, 0u, 0u}; if (!first) ov[m][bj] = *(const u32x4*)(mrg + (size_t)row * DM + col0 + bj * 128);
                }
#pragma unroll
            for (int m = 0; m < 4; ++m)
#pragma unroll
                for (int bj = 0; bj < 2; ++bj) {
                    const int row = row0 + ai * 128 + m * 16;
                    const u32x4 g = gv[m][bj], o = ov[m][bj]; const pg8::f32x4 a0 = acc[ai][bj][m][0], a1 = acc[ai][bj][m][1];
                    u32x4 w; w.x = pk2(bflo(o.x) + bflo(g.x) * a0[0], bfhi(o.x) + bfhi(g.x) * a0[1]); w.y = pk2(bflo(o.y) + bflo(g.y) * a0[2], bfhi(o.y) + bfhi(g.y) * a0[3]);
                    w.z = pk2(bflo(o.z) + bflo(g.z) * a1[0], bfhi(o.z) + bfhi(g.z) * a1[1]); w.w = pk2(bflo(o.w) + bflo(g.w) * a1[2], bfhi(o.w) + bfhi(g.w) * a1[3]);
                    *(u32x4*)(mrg + (size_t)row * DM + col0 + bj * 128) = w;
                }
            asm volatile("" ::: "memory");
        }
    }
};

__device__ __forceinline__ void transpose_tile(const float* src, int srcN, const float* gk, bf16_t* dst, int dstK, LAS float* scr, int lane) {
    float tv[32];
#pragma unroll
    for (int i = 0; i < 32; ++i) tv[i] = src[(size_t)(2 * i + (lane >> 5)) * srcN + (lane & 31)];
    if (gk) {
#pragma unroll
        for (int i = 0; i < 32; ++i) tv[i] *= gk[2 * i + (lane >> 5)];
    }
#pragma unroll
    for (int i = 0; i < 32; ++i) scr[(2 * i + (lane >> 5)) * 33 + (lane & 31)] = tv[i];
    asm volatile("s_waitcnt lgkmcnt(0)" ::: "memory");
    const int c = lane & 7;
#pragma unroll
    for (int j = 0; j < 4; ++j) {
        const int n = (lane >> 3) + 8 * j; const LAS float* s = scr + (8 * c) * 33 + n;
        u32x4 o; o.x = pk2(s[0 * 33], s[1 * 33]); o.y = pk2(s[2 * 33], s[3 * 33]); o.z = pk2(s[4 * 33], s[5 * 33]); o.w = pk2(s[6 * 33], s[7 * 33]);
        *(u32x4*)(dst + (size_t)n * dstK + 8 * c) = o;
    }
    asm volatile("s_waitcnt lgkmcnt(0)" ::: "memory");
}
constexpr int CV_I_GU = (2 * DFF / 32) * (DM / 64), CV_I_D = (DM / 32) * (DFF / 64), CV_I_ING = ((NPROJ + NGATE) / 32) * (DM / 64), CV_I_B = (DM / 32) * (512 / 64), CV_I_O = (DM / 32) * (DM / 64);
constexpr int CV_NITEMS = 2 * CV_I_GU + 2 * CV_I_D + CV_I_ING + 3 * CV_I_B + CV_I_O;
constexpr int CV_CUT1 = (CV_NITEMS * 2) / 5, CV_CUT2 = (CV_NITEMS * 4) / 5;
__device__ __forceinline__ void convert_layer(const Params& p, int l, LAS unsigned char* lds, int it_lo, int it_hi, int worker, int nworkers) {
    const int tid = pg8::pg8_opaque_tid(), lane = tid & 63, wid = __builtin_amdgcn_readfirstlane(tid >> 6);
    LAS float* scr = (LAS float*)(lds + wid * 8448);
    bf16_t* W = (bf16_t*)(p.ws + B_W) + (size_t)(l & 1) * E_WTOT;
    const float* ng = p.norm_g + (size_t)l * 3 * DM;
    constexpr int I_GU = CV_I_GU, I_D = CV_I_D, I_ING = CV_I_ING, I_B = CV_I_B;
    for (int it = it_lo + worker * 8 + wid; it < it_hi; it += nworkers * 8) {
        int r = it;
        if (r < 2 * I_GU) {
            const int f = r / I_GU; r -= f * I_GU; const int nb = r / (DM / 64), kb = r % (DM / 64), n0 = nb * 32, k0 = kb * 64;
            const int pn = n0 >> 8, w = n0 & 255; const float* src = ((w < 128) ? p.ffn_w_gate : p.ffn_w_up) + (size_t)(l * 2 + f) * DM * DFF;
            transpose_tile(src + (size_t)k0 * DFF + pn * 128 + (w & 127), DFF, ng + (f ? 2 : 0) * DM + k0, W + (f ? O_WGU1 : O_WGU0) + (size_t)n0 * DM + k0, DM, scr, lane); continue; }
        r -= 2 * I_GU;
        if (r < 2 * I_D) {
            const int f = r / I_D; r -= f * I_D; const int nb = r / (DFF / 64), kb = r % (DFF / 64), n0 = nb * 32, k0 = kb * 64;
            const float* src = p.ffn_w_down + (size_t)(l * 2 + f) * DFF * DM;
            transpose_tile(src + (size_t)k0 * DM + n0, DM, nullptr, W + (f ? O_WD1 : O_WD0) + (size_t)n0 * DFF + k0, DFF, scr, lane); continue; }
        r -= 2 * I_D;
        if (r < I_ING) {
            const int nb = r / (DM / 64), kb = r % (DM / 64), n0 = nb * 32, k0 = kb * 64;
            if (n0 < NPROJ) transpose_tile(p.w_in + (size_t)l * DM * NPROJ + (size_t)k0 * NPROJ + n0, NPROJ, ng + DM + k0, W + O_WING + (size_t)n0 * DM + k0, DM, scr, lane);
            else transpose_tile(p.w_gate + (size_t)l * DM * NGATE + (size_t)k0 * NGATE + (n0 - NPROJ), NGATE, ng + DM + k0, W + O_WING + (size_t)n0 * DM + k0, DM, scr, lane);
            continue; }
        r -= I_ING;
        if (r < 3 * I_B) {
            const int i = r / I_B; r -= i * I_B; const int nb = r / 8, kb = r % 8, n0 = nb * 32, k0 = kb * 64;
            transpose_tile(p.w_branch + (size_t)(l * 3 + i) * 512 * DM + (size_t)k0 * DM + n0, DM, nullptr, W + O_WB + (size_t)i * E_WB + (size_t)n0 * 512 + k0, 512, scr, lane); continue; }
        r -= 3 * I_B;
        {
            const int nb = r / (DM / 64), kb = r % (DM / 64), n0 = nb * 32, k0 = kb * 64;
            transpose_tile(p.w_o + (size_t)l * DM * DM + (size_t)k0 * DM + n0, DM, nullptr, W + O_WO + (size_t)n0 * DM + k0, DM, scr, lane); }
    }
}

__device__ __forceinline__ void prologue_rows(const float* x, bf16_t* xb, float* ssq) {
    const int tid = pg8::pg8_opaque_tid(), lane = tid & 63, wid = __builtin_amdgcn_readfirstlane(tid >> 6);
    const int gw = blockIdx.x * 8 + wid, NGW = gridDim.x * 8;
    for (int row0 = gw; row0 < S; row0 += 2 * NGW) {
        f32x4 v[2][4];
#pragma unroll
        for (int h = 0; h < 2; ++h)
#pragma unroll
            for (int j = 0; j < 4; ++j) v[h][j] = *((const f32x4*)(x + (size_t)(row0 + h * NGW) * DM) + lane + 64 * j);
#pragma unroll
        for (int h = 0; h < 2; ++h) {
            const int row = row0 + h * NGW; u32x2* o = (u32x2*)(xb + (size_t)row * DM) + lane; float ss = 0.f;
#pragma unroll
            for (int j = 0; j < 4; ++j) { const f32x4 t = v[h][j]; ss += (t.x * t.x + t.y * t.y) + (t.z * t.z + t.w * t.w); u32x2 w; w.x = pk2(t.x, t.y); w.y = pk2(t.z, t.w); o[64 * j] = w; }
            ss = wave_sum(ss);
            if (lane < 16) ssq[(size_t)row * 16 + lane] = (lane == 0) ? ss : 0.f;
        }
    }
}
__device__ __forceinline__ void final_norm(float* x, const float* g) {
    const int tid = pg8::pg8_opaque_tid(), lane = tid & 63, wid = __builtin_amdgcn_readfirstlane(tid >> 6);
    const int gw = blockIdx.x * 8 + wid, NGW = gridDim.x * 8;
    f32x4 gv[4];
#pragma unroll
    for (int j = 0; j < 4; ++j) gv[j] = *((const f32x4*)g + lane + 64 * j);
    for (int row0 = gw; row0 < S; row0 += 2 * NGW) {
        f32x4 v[2][4];
#pragma unroll
        for (int h = 0; h < 2; ++h)
#pragma unroll
            for (int j = 0; j < 4; ++j) v[h][j] = *((const f32x4*)(x + (size_t)(row0 + h * NGW) * DM) + lane + 64 * j);
#pragma unroll
        for (int h = 0; h < 2; ++h) {
            f32x4* xr = (f32x4*)(x + (size_t)(row0 + h * NGW) * DM) + lane; float ss = 0.f;
#pragma unroll
            for (int j = 0; j < 4; ++j) ss += (v[h][j].x * v[h][j].x + v[h][j].y * v[h][j].y) + (v[h][j].z * v[h][j].z + v[h][j].w * v[h][j].w);
            const float rstd = 1.0f / sqrtf(wave_sum(ss) * (1.0f / DM) + 1e-6f);
#pragma unroll
            for (int j = 0; j < 4; ++j) xr[64 * j] = v[h][j] * rstd * gv[j];
        }
    }
}

__device__ __forceinline__ float max2m(float a, float b) { return __builtin_amdgcn_fmed3f(a, b, __builtin_inff()); }
__device__ __forceinline__ float max3f(float a, float b, float c) { return max2m(max2m(a, b), c); }
__device__ __forceinline__ int crow(int r, int hi) { return (r & 3) + 8 * (r >> 2) + 4 * hi; }
__device__ __forceinline__ int t5_bucket(int rel) {
    const int n = rel < 0 ? -rel : rel; int b;
    if (n < 8) b = n; else if (n < 12) b = 8; else if (n < 16) b = 9; else if (n < 23) b = 10; else if (n < 32) b = 11; else if (n < 46) b = 12; else if (n < 64) b = 13; else if (n < 91) b = 14; else b = 15;
    return b + (rel > 0 ? 16 : 0);
}
typedef short v4i16_t __attribute__((ext_vector_type(4)));
__device__ __forceinline__ s16x4 tr_read(const LAS unsigned char* p) { return __builtin_bit_cast(s16x4, __builtin_amdgcn_ds_read_tr16_b64_v4i16((LAS v4i16_t*)p)); }

template <int MODE, bool FROZEN = false>
__device__ __forceinline__ bool attn_unit(LAS unsigned char* lds, const Params& p, int l, int ua, int ub) {
    constexpr int KW = (MODE == 1) ? 128 : 64, DV = (MODE == 1) ? 128 : 64, NB = DV / 32;
    constexpr int KPB = KW * 2 + 16, VTP = 144, KBUF = 64 * KPB, VBUF = DV * VTP;
    constexpr int OFF_K = 0, OFF_V = 2 * KBUF, OFF_LUT = 2 * KBUF + 2 * VBUF;
    constexpr int KCH = KW / 8, NKC = 64 * KCH / 512, NVC = DV * 8 / 512;
    const int tid = pg8::pg8_opaque_tid(), lane = tid & 63, wid = __builtin_amdgcn_readfirstlane(tid >> 6), r32 = lane & 31, hi = lane >> 5;
    const bf16_t* proj = (const bf16_t*)(p.ws + B_PROJ);
    const bf16_t* vtg = (const bf16_t*)(p.ws + B_VT);
    LAS float* lut = (LAS float*)(lds + OFF_LUT);

    int qtok0, qcol, kcol, vcol, kfo = 0, ocol = 0, kt0, NT, wt_lo = 0, wt_hi, lut_sel = 0, myrow = 0;
    bf16_t* obuf = (bf16_t*)(p.ws + B_Y) + (size_t)MODE * S * 512;
    float m_run = NEGBIG, l_run = 0.f, lam = 0.f, lam_init = 0.f;
    if constexpr (MODE == 0) {
        const int h = ua, R0 = ub * 4; myrow = R0 + (wid >> 1); qtok0 = myrow * 64 + (wid & 1) * 32;
        qcol = h * 64; kcol = 512 + h * 64; vcol = h * 64; ocol = h * 64;
        const int rs_first = min(max(R0 - 4, 0), 248), rs_last = min(max(R0 + 3 - 4, 0), 248), my_rs = min(max(myrow - 4, 0), 248);
        kt0 = rs_first * 64; NT = rs_last + 8 - rs_first; wt_lo = my_rs - rs_first; wt_hi = wt_lo + 8;
        for (int i = tid; i < 15 * 127; i += 512) { const int dr_ = i / 127, dc_ = min(max(i % 127 - 48, 0), 30); lut[i] = p.na_rpb[(size_t)(l * 8 + h) * 465 + dr_ * 31 + dc_] * LOG2E; }
    } else if constexpr (MODE == 1) {
        const int h = ua, qb = ub, c = wid >> 2; qtok0 = qb * 128 + (wid & 3) * 32;
        qcol = 1536 + h * 128 + c * 64; kcol = 2048 + h * 128; kfo = c * 64; vcol = 512 + h * 128; ocol = h * 128;
        kt0 = 0; NT = S / 64; wt_hi = NT;
        for (int i = tid; i < 449; i += 512) lut[i] = p.rel_bias[t5_bucket(i - 224) * 12 + h] * LOG2E;
        const float* lq = p.diff_lambda + (size_t)l * 256;
        const float s1 = wave_sum(lq[lane] * lq[64 + lane]), s2 = wave_sum(lq[128 + lane] * lq[192 + lane]);
        lam_init = 0.8f - 0.6f * expf(-0.3f * (float)l);
        lam = expf(s1) - expf(s2) + lam_init;
    } else {
        const int g = ua, qb = ub, hq = g * 4 + (wid >> 1); qtok0 = qb * 64 + (wid & 1) * 32; lut_sel = wid >> 1;
        qcol = 3072 + hq * 64; kcol = 3584 + g * 64; vcol = 1024 + g * 64; ocol = hq * 64;
        const int tlo = max(qb - 2, 0), thi = min(qb + 2, S / 64 - 1); kt0 = tlo * 64; NT = thi - tlo + 1; wt_hi = NT;
        for (int i = tid; i < 4 * 449; i += 512) { const int hh = i / 449, rel = i % 449 - 224; lut[i] = (rel >= -128 && rel <= 128) ? p.rel_bias[t5_bucket(rel) * 12 + 4 + g * 4 + hh] * LOG2E : NEGBIG; }
        m_run = p.gqa_sink[l * 8 + hq] * LOG2E; l_run = (hi == 0) ? 1.0f : 0.0f;
    }
    bf16x8 qf[4];
    { const bf16_t* qp = proj + (size_t)(qtok0 + r32) * NPROJ + qcol + 8 * hi;
#pragma unroll
      for (int d0 = 0; d0 < 4; ++d0) qf[d0] = *(const bf16x8*)(qp + 16 * d0); }
    f32x16 o[NB];
#pragma unroll
    for (int nb = 0; nb < NB; ++nb)
#pragma unroll
        for (int r = 0; r < 16; ++r) o[nb][r] = 0.f;

    u32x4 kr[NKC], vr[NVC];
    unsigned ksrc[NKC], vsrc[NVC]; int kdst[NKC], vdst[NVC];
    const bf16_t* kvbase = proj + (size_t)kt0 * NPROJ;
#pragma unroll
    for (int i = 0; i < NKC; ++i) { const int cid = tid + 512 * i, row = cid / KCH, ch = cid % KCH; ksrc[i] = (unsigned)(row * NPROJ + kcol + ch * 8); kdst[i] = OFF_K + row * KPB + ch * 16; }
#pragma unroll
    for (int i = 0; i < NVC; ++i) { const int cid = tid + 512 * i, row = cid >> 3, ch = cid & 7; vsrc[i] = (unsigned)((vcol + row) * S + ch * 8); vdst[i] = OFF_V + row * VTP + (ch >> 1) * 32 + (ch & 1) * 8; }
    const bf16_t* vtbase = vtg + kt0;
    {
        u32x4 k1[NKC];
#pragma unroll
        for (int i = 0; i < NKC; ++i) { kr[i] = *(const u32x4*)(kvbase + ksrc[i]); k1[i] = *(const u32x4*)(kvbase + (size_t)64 * NPROJ + ksrc[i]); }
#pragma unroll
        for (int i = 0; i < NVC; ++i) vr[i] = *(const u32x4*)(vtbase + vsrc[i]);
#pragma unroll
        for (int i = 0; i < NKC; ++i) { *(LAS u32x4*)(lds + kdst[i]) = kr[i]; *(LAS u32x4*)(lds + kdst[i] + KBUF) = k1[i]; }
#pragma unroll
        for (int i = 0; i < NVC; ++i) { *(LAS u32x2*)(lds + vdst[i]) = (u32x2){vr[i].x, vr[i].y}; *(LAS u32x2*)(lds + vdst[i] + 16) = (u32x2){vr[i].z, vr[i].w}; }
#pragma unroll
        for (int i = 0; i < NKC; ++i) kr[i] = *(const u32x4*)(kvbase + (size_t)2 * 64 * NPROJ + ksrc[i]);
#pragma unroll
        for (int i = 0; i < NVC; ++i) vr[i] = *(const u32x4*)(vtbase + 64 + vsrc[i]);
    }
    __syncthreads();

    const int qpos = qtok0 + r32;
    const int i16 = lane & 15, q4 = i16 >> 2, p4 = i16 & 3, blk = (lane >> 4) & 1;
    const int vlane_off = r32 * VTP + hi * 16;
    const int klane_off = r32 * KPB + (kfo + 8 * hi) * 2;

    f32x16 sB0, sB1; float cbB = 0.f; bool fastB = false;
#define ATT_QK(tt) do { const LAS unsigned char* Kb_ = lds + OFF_K + ((tt) & 1) * KBUF + klane_off; \
        f32x16 z0_, z1_; _Pragma("unroll") for (int r = 0; r < 16; ++r) { z0_[r] = 0.f; z1_[r] = 0.f; } \
        _Pragma("unroll") for (int d0 = 0; d0 < 4; ++d0) { \
            const bf16x8 k0_ = *(const LAS bf16x8*)(Kb_ + d0 * 32), k1_ = *(const LAS bf16x8*)(Kb_ + 32 * KPB + d0 * 32); \
            z0_ = __builtin_amdgcn_mfma_f32_32x32x16_bf16(k0_, qf[d0], z0_, 0, 0, 0); z1_ = __builtin_amdgcn_mfma_f32_32x32x16_bf16(k1_, qf[d0], z1_, 0, 0, 0); } \
        sB0 = z0_; sB1 = z1_; } while (0)
#define ATT_MAX3(dst) do { float tm_ = max3f(sB0[0], sB1[0], sB0[1]), tn_ = max3f(sB1[1], sB0[2], sB1[2]); \
        _Pragma("unroll") for (int r = 3; r < 15; r += 2) { tm_ = max3f(tm_, sB0[r], sB1[r]); tn_ = max3f(tn_, sB0[r + 1], sB1[r + 1]); } \
        tm_ = max3f(tm_, sB0[15], sB1[15]); dst = max3f(tm_, tn_, tn_); } while (0)
#define ATT_BIAS(tt, tmraw) do { const int ktok_ = kt0 + 64 * (tt); bool fast_ = false; cbB = 0.f; const float nm_ = FROZEN ? -m_run : 0.f; \
        if constexpr (MODE == 1) { if (ktok_ - (qtok0 + 31) >= 128) { cbB = cb_pos; fast_ = true; } else if (qtok0 - (ktok_ + 63) >= 128) { cbB = cb_neg; fast_ = true; } } \
        if (!fast_) { \
            if constexpr (MODE != 0) { \
                const LAS float* lp_ = lut + (ktok_ - qpos + 224 + 4 * hi + (MODE == 2 ? lut_sel * 449 : 0)); \
                _Pragma("unroll") for (int r = 0; r < 16; ++r) { const int cr_ = (r & 3) + 8 * (r >> 2); sB0[r] += lp_[cr_] + nm_; if ((r & 7) == 7) __builtin_amdgcn_sched_barrier(0); } \
                _Pragma("unroll") for (int r = 0; r < 16; ++r) { const int cr_ = (r & 3) + 8 * (r >> 2); sB1[r] += lp_[cr_ + 32] + nm_; if ((r & 7) == 7) __builtin_amdgcn_sched_barrier(0); } \
            } else { \
                if (!((tt) >= wt_lo && (tt) < wt_hi)) { _Pragma("unroll") for (int r = 0; r < 16; ++r) { sB0[r] = -INFINITY; sB1[r] = -INFINITY; } } \
                else { \
                    const int qc = (wid & 1) * 32 + r32, cs = min(max(qc - 8, 0), 48), dr = min(max((kt0 >> 6) + (tt) - myrow + 7, 0), 14); \
                    const LAS float* lp_ = lut + (dr * 127 + 63 - qc + 4 * hi); const int kb_ = 4 * hi - cs; \
                    _Pragma("unroll") for (int r = 0; r < 16; ++r) { const int cr_ = (r & 3) + 8 * (r >> 2); \
                        sB0[r] = ((unsigned)(kb_ + cr_) < 16u) ? sB0[r] + lp_[cr_] : NEGBIG; sB1[r] = ((unsigned)(kb_ + cr_ + 32) < 16u) ? sB1[r] + lp_[cr_ + 32] : NEGBIG; if ((r & 3) == 3) __builtin_amdgcn_sched_barrier(0); } \
                } } if constexpr (!FROZEN) ATT_MAX3(tmraw); } \
        fastB = fast_; \
    } while (0)
#define ATT_UPD(tmraw) do { \
        if constexpr (FROZEN) {              \
            if (fastB && __any(cbB != m_run)) { \
                const float f_ = fast_exp2(m_run - cbB); l_run *= f_; m_run = cbB; \
                _Pragma("unroll") for (int nb = 0; nb < NB; ++nb) _Pragma("unroll") for (int r = 0; r < 16; ++r) o[nb][r] *= f_; } \
        } else { \
            const float tm_ = xhalf_max(tmraw) + cbB; \
            if (__any(tm_ > m_run)) { \
                const float mn_ = fmaxf(m_run, tm_), f_ = fast_exp2(m_run - mn_); l_run *= f_; m_run = mn_; \
                _Pragma("unroll") for (int nb = 0; nb < NB; ++nb) _Pragma("unroll") for (int r = 0; r < 16; ++r) o[nb][r] *= f_; } } \
    } while (0)

    float cb_pos = 0.f, cb_neg = 0.f;
    if constexpr (MODE == 1) { cb_pos = lut[448]; cb_neg = lut[0]; }
    ATT_QK(0);
    if constexpr (FROZEN) m_run = cb_neg;
    { float tm0 = 0.f; if constexpr (!FROZEN) ATT_MAX3(tm0); ATT_BIAS(0, tm0); ATT_UPD(tm0); }
    __syncthreads();

    for (int t = 0; t < NT; ++t) {
        if (t + 2 < NT) {
#pragma unroll
            for (int i = 0; i < NKC; ++i) *(LAS u32x4*)(lds + kdst[i] + (t & 1) * KBUF) = kr[i];
        }
        if (t + 1 < NT) {
#pragma unroll
            for (int i = 0; i < NVC; ++i) { *(LAS u32x2*)(lds + vdst[i] + ((t + 1) & 1) * VBUF) = (u32x2){vr[i].x, vr[i].y}; *(LAS u32x2*)(lds + vdst[i] + ((t + 1) & 1) * VBUF + 16) = (u32x2){vr[i].z, vr[i].w}; }
        }
        {
            const size_t advk = (size_t)min(t + 3, NT - 1) * 64 * NPROJ, advv = (size_t)min(t + 2, NT - 1) * 64;
#pragma unroll
            for (int i = 0; i < NKC; ++i) kr[i] = *(const u32x4*)(kvbase + advk + ksrc[i]);
#pragma unroll
            for (int i = 0; i < NVC; ++i) vr[i] = *(const u32x4*)(vtbase + advv + vsrc[i]);
        }
        f32x16 sA0 = sB0, sA1 = sB1;
        const float c2 = cbB - m_run;
        const LAS unsigned char* Vb = lds + OFF_V + (t & 1) * VBUF + vlane_off;
        const LAS unsigned char* Kb = lds + OFF_K + ((t + 1) & 1) * KBUF + klane_off;
#define SA_(ks, j) ((((ks) >> 1) == 0) ? sA0[8 * ((ks) & 1) + (j)] : sA1[8 * ((ks) & 1) + (j)])
#define EXPCVT(ks, PF, PSUM) do { float x_[8]; _Pragma("unroll") for (int j = 0; j < 8; ++j) x_[j] = FROZEN ? fast_exp2(SA_(ks, j)) : fast_exp2(SA_(ks, j) + c2); \
        PSUM = ((x_[0] + x_[1]) + (x_[2] + x_[3])) + ((x_[4] + x_[5]) + (x_[6] + x_[7])); \
        u32x4 pw_; pw_.x = pk2(x_[0], x_[1]); pw_.y = pk2(x_[2], x_[3]); pw_.z = pk2(x_[4], x_[5]); pw_.w = pk2(x_[6], x_[7]); PF = __builtin_bit_cast(bf16x8, pw_); } while (0)
#define VLOAD(ks, DST) do { const LAS unsigned char* vp_ = Vb + (ks) * 32; \
        _Pragma("unroll") for (int nb = 0; nb < NB; ++nb) DST[nb] = *(const LAS bf16x8*)(vp_ + nb * 32 * VTP); } while (0)
#define PVMMA(SRC, PF) do { _Pragma("unroll") for (int nb = 0; nb < NB; ++nb) o[nb] = __builtin_amdgcn_mfma_f32_32x32x16_bf16(SRC[nb], PF, o[nb], 0, 0, 0); } while (0)
#define SBAR_() __builtin_amdgcn_sched_barrier(0)
        bf16x8 kf0[4], kf1[4], va[NB], vb[NB], pf0, pf1; float ps0, ps1, ps2, ps3;
        VLOAD(0, va);
        EXPCVT(0, pf0, ps0);
        SBAR_();
        VLOAD(1, vb); PVMMA(va, pf0); EXPCVT(1, pf1, ps1); SBAR_();
        VLOAD(2, va);
#pragma unroll
        for (int d0 = 0; d0 < 4; ++d0) { kf0[d0] = *(const LAS bf16x8*)(Kb + d0 * 32); kf1[d0] = *(const LAS bf16x8*)(Kb + 32 * KPB + d0 * 32); }
        PVMMA(vb, pf1); EXPCVT(2, pf0, ps2); SBAR_();
        {
            f32x16 z0, z1;
#pragma unroll
            for (int r = 0; r < 16; ++r) { z0[r] = 0.f; z1[r] = 0.f; }
#pragma unroll
            for (int d0 = 0; d0 < 4; ++d0) { z0 = __builtin_amdgcn_mfma_f32_32x32x16_bf16(kf0[d0], qf[d0], z0, 0, 0, 0); z1 = __builtin_amdgcn_mfma_f32_32x32x16_bf16(kf1[d0], qf[d0], z1, 0, 0, 0); }
            sB0 = z0; sB1 = z1;
        }
        EXPCVT(3, pf1, ps3);
        SBAR_();
        float tmr;
        VLOAD(3, vb); SBAR_();
        PVMMA(va, pf0); if constexpr (!FROZEN) ATT_MAX3(tmr); else tmr = 0.f; PVMMA(vb, pf1);
        const float ps = (ps0 + ps1) + (ps2 + ps3);
#undef SA_
#undef EXPCVT
#undef VLOAD
#undef PVMMA
#undef SBAR_
        l_run += ps;
        if (t + 1 < NT) { ATT_BIAS(t + 1, tmr); ATT_UPD(tmr); }
        asm volatile("s_waitcnt lgkmcnt(0)" ::: "memory"); __builtin_amdgcn_s_barrier(); asm volatile("" ::: "memory");
    }
    __syncthreads();
#undef ATT_QK
#undef ATT_BIAS
#undef ATT_UPD
#undef ATT_MAX3
    if constexpr (FROZEN) {
        const float lt_ = xhalf_sum(l_run); const bool bad_ = !(lt_ > 0x1p-60f && lt_ < 0x1p60f);
        LAS unsigned* flg_ = (LAS unsigned*)(lds + OFF_LUT + 4096);
        if (tid == 0) *flg_ = 0u;
        __syncthreads();
        if (__any(bad_) && lane == 0) *flg_ = 1u;
        __syncthreads();
        const bool redo_ = (*flg_ != 0u);
        __syncthreads();
        if (redo_) return false;
    }
    const float linv = 1.0f / xhalf_sum(l_run);
#pragma unroll
    for (int nb = 0; nb < NB; ++nb)
#pragma unroll
        for (int r = 0; r < 16; ++r) o[nb][r] *= linv;
    if constexpr (MODE == 1) {
        LAS float* ex = (LAS float*)lds;
        if (wid >= 4) {
#pragma unroll
            for (int nb = 0; nb < NB; ++nb)
#pragma unroll
                for (int r = 0; r < 16; ++r) ex[((wid - 4) * 64 + nb * 16 + r) * 64 + lane] = o[nb][r];
        }
        __syncthreads();
        if (wid < 4) {
            float ss = 0.f;
#pragma unroll
            for (int nb = 0; nb < NB; ++nb)
#pragma unroll
                for (int r = 0; r < 16; ++r) { const float a = o[nb][r] - lam * ex[(wid * 64 + nb * 16 + r) * 64 + lane]; o[nb][r] = a; ss += a * a; }
            ss = xhalf_sum(ss);
            const float rinv = (1.0f - lam_init) / sqrtf(ss * (1.0f / 128.0f) + 1e-6f);
            const float* sg = p.diff_subln_g + (size_t)l * 128;
            bf16_t* op = obuf + (size_t)qpos * 512 + ocol;
#pragma unroll
            for (int nb = 0; nb < NB; ++nb)
#pragma unroll
                for (int rq = 0; rq < 4; ++rq) {
                    const int dv = 32 * nb + 8 * rq + 4 * hi; const f32x4 gg = *(const f32x4*)(sg + dv);
                    u32x2 w; w.x = pk2(o[nb][4 * rq] * rinv * gg.x, o[nb][4 * rq + 1] * rinv * gg.y); w.y = pk2(o[nb][4 * rq + 2] * rinv * gg.z, o[nb][4 * rq + 3] * rinv * gg.w);
                    *(u32x2*)(op + dv) = w;
                }
        }
        __syncthreads();
    } else {
        bf16_t* op = obuf + (size_t)qpos * 512 + ocol;
#pragma unroll
        for (int nb = 0; nb < NB; ++nb)
#pragma unroll
            for (int rq = 0; rq < 4; ++rq) {
                const int dv = 32 * nb + 8 * rq + 4 * hi;
                u32x2 w; w.x = pk2(o[nb][4 * rq], o[nb][4 * rq + 1]); w.y = pk2(o[nb][4 * rq + 2], o[nb][4 * rq + 3]);
                *(u32x2*)(op + dv) = w;
            }
    }
    return true;
}

__device__ __forceinline__ void attn_phase(LAS unsigned char* lds, const Params& p, int l) {
    unsigned redo_mask = 0u; int ui_ = 0;
    for (int u = blockIdx.x; u < 512; u += gridDim.x, ++ui_) { const int x = u & 7; if (!attn_unit<1, true>(lds, p, l, x >> 1, (x & 1) * 64 + (u >> 3))) redo_mask |= 1u << (ui_ & 31); }
    asm volatile("" : "+s"(redo_mask) :: "memory");
    if (redo_mask) {
        ui_ = 0;
        for (int u = blockIdx.x; u < 512; u += gridDim.x, ++ui_) { int x = u & 7, j = u >> 3; asm volatile("" : "+s"(x), "+s"(j)); if (redo_mask & (1u << (ui_ & 31))) (void)attn_unit<1, false>(lds, p, l, x >> 1, (x & 1) * 64 + j); }
    }
    for (int u = blockIdx.x; u < 512; u += gridDim.x) (void)attn_unit<0>(lds, p, l, u & 7, u >> 3);
    for (int u = blockIdx.x; u < 512; u += gridDim.x) (void)attn_unit<2>(lds, p, l, u & 1, u >> 1);
}

#define XB_TMO      128
#define XB_XCNT(j)  (256  + 64 * (j))
#define XB_XSUB(j)  (1280 + 64 * (j))
#define XB_XGEN(j)  (2304 + 64 * (j))
#define XB_TOP      3328
#define XB_TOPGEN   3392
#define XCD_BAR_WORDS 3456
#define XB_SPIN_CAP (1u << 18)

__device__ __forceinline__ unsigned xb_ld(unsigned* p)              { return __hip_atomic_load(p, __ATOMIC_RELAXED, __HIP_MEMORY_SCOPE_AGENT); }
__device__ __forceinline__ unsigned xb_add(unsigned* p, unsigned v) { return __hip_atomic_fetch_add(p, v, __ATOMIC_RELAXED, __HIP_MEMORY_SCOPE_AGENT); }
__device__ __forceinline__ unsigned xb_xcc_id() { return (unsigned)__builtin_amdgcn_s_getreg((3 << 11) | 20) & 0xFu; }
#define XB_SPIN(cond, bar) do { unsigned _sp = 0; while (cond) { __builtin_amdgcn_s_sleep(1); \
    if ((++_sp & 255u) == 0u) { if (xb_ld(&(bar)[XB_TMO])) break; if (_sp > XB_SPIN_CAP) { atomicAdd(&(bar)[XB_TMO], 1u); break; } } } } while (0)

struct XcdBarrier {
    unsigned* bar; unsigned x;
    volatile LAS unsigned* st;
};

__device__ __forceinline__ XcdBarrier xcd_barrier_post(unsigned* bar, volatile LAS unsigned* st) {
    XcdBarrier b; b.bar = bar; b.x = xb_xcc_id(); b.st = st;
    if (threadIdx.x == 0) (void)xb_add(&bar[XB_XCNT(b.x)], 1u);
    return b;
}
__device__ __forceinline__ void xcd_barrier_complete(unsigned* bar, unsigned x, unsigned& nloc, unsigned& nx) {
    const unsigned G = gridDim.x * gridDim.y * gridDim.z;
    unsigned sum, cnt, mine, sp = 0u;
    for (;;) {
        sum = 0u; cnt = 0u; mine = 0u;
#pragma unroll
        for (unsigned j = 0; j < 16; ++j) { const unsigned c = xb_ld(&bar[XB_XCNT(j)]); sum += c; cnt += (c > 0u) ? 1u : 0u; mine = (j == x) ? c : mine; }
        if (sum == G) break;
        __builtin_amdgcn_s_sleep(1);
        if ((++sp & 255u) == 0u) { if (xb_ld(&bar[XB_TMO])) break; if (sp > XB_SPIN_CAP) { atomicAdd(&bar[XB_TMO], 1u); break; } }
    }
    nloc = mine > 0u ? mine : 1u; nx = cnt > 0u ? cnt : 1u;
}

__device__ __forceinline__ void xcd_barrier(const XcdBarrier& b) {
    asm volatile("s_waitcnt vmcnt(0)" ::: "memory");
    __syncthreads();
    if (threadIdx.x == 0) {
        unsigned* bar = b.bar;
        __builtin_amdgcn_s_waitcnt(0);
        unsigned nloc = b.st[0], nx = b.st[1];
        if (nloc == 0u) { xcd_barrier_complete(bar, b.x, nloc, nx); b.st[0] = nloc; b.st[1] = nx; }
        const unsigned old = xb_add(&bar[XB_XSUB(b.x)], 1u);
        const unsigned gen = old / nloc;
        if (old + 1u == (gen + 1u) * nloc) {
            __builtin_amdgcn_fence(__ATOMIC_RELEASE, "agent");
            asm volatile("s_waitcnt vmcnt(0)" ::: "memory");
            const unsigned og = xb_add(&bar[XB_TOP], 1u);
            const unsigned tg = og / nx;
            if (og + 1u == (tg + 1u) * nx) xb_add(&bar[XB_TOPGEN], 1u);
            else XB_SPIN(xb_ld(&bar[XB_TOPGEN]) == tg, bar);
            __builtin_amdgcn_fence(__ATOMIC_ACQUIRE, "agent");
            xb_add(&bar[XB_XGEN(b.x)], 1u);
            asm volatile("s_waitcnt vmcnt(0)" ::: "memory");
        } else {
            XB_SPIN(xb_ld(&bar[XB_XGEN(b.x)]) == gen, bar);
            __builtin_amdgcn_fence(__ATOMIC_ACQUIRE, "agent");
            asm volatile("s_waitcnt vmcnt(0)" ::: "memory");
        }
    }
    __syncthreads();
}

__global__ void __launch_bounds__(512) mk_fwd(Params p) {
    extern __shared__ __attribute__((aligned(16))) unsigned char lds_raw[];
    LAS unsigned char* lds = (LAS unsigned char*)lds_raw;
    cg::grid_group grid = cg::this_grid();
    volatile LAS unsigned* bst = (volatile LAS unsigned*)(lds + 131072);
    if (threadIdx.x < 4) bst[threadIdx.x] = 0u;
    __syncthreads();
    const XcdBarrier bar = xcd_barrier_post((unsigned*)(p.ws + B_BAR), bst);
    bf16_t* XB = (bf16_t*)(p.ws + B_XB); bf16_t* PROJ = (bf16_t*)(p.ws + B_PROJ); bf16_t* G = (bf16_t*)(p.ws + B_G); bf16_t* Y = (bf16_t*)(p.ws + B_Y); bf16_t* MRG = (bf16_t*)(p.ws + B_MRG);
    float* SSQ = (float*)(p.ws + B_SSQ);
    bf16_t* HID = G;
    for (int step = p.step_lo; step < p.step_hi; ++step) {
        if (step == 0) {
            {
                const int t_ = pg8::pg8_opaque_tid(); unsigned acc_ = 0u;
                for (size_t o_ = (size_t)t_ * 65536; o_ < B_END; o_ += (size_t)512 * 65536) acc_ += __builtin_nontemporal_load((const unsigned*)(p.ws + o_));
                for (size_t o_ = (size_t)t_ * 65536; o_ < (size_t)S * DM * 4; o_ += (size_t)512 * 65536) acc_ += __builtin_nontemporal_load((const unsigned*)((const unsigned char*)p.out + o_));
                if (acc_ == 0x12345677u && p.step_hi < 0) ((unsigned*)(p.ws + B_BAR))[1000] = acc_;
            }
            convert_layer(p, 0, lds, 0, CV_NITEMS, (int)blockIdx.x, (int)gridDim.x);
            prologue_rows(p.x, XB, SSQ);
        } else if (step == NSTEPS - 1) {
            final_norm(p.out, p.final_g);
        } else {
            const int l = (step - 1) / NSTEP_PER_LAYER, s = (step - 1) - l * NSTEP_PER_LAYER;
            bf16_t* W = (bf16_t*)(p.ws + B_W) + (size_t)(l & 1) * E_WTOT;
            if (s == 0 || s == 6) {
                pg8::Gemm g{XB, W + (s == 6 ? O_WGU1 : O_WGU0), S, 2 * DFF, DM}; pg8::StaticOrder So; So.init(S, 2 * DFF, gridDim.x, blockIdx.x);
                EpiSwiGLU E{HID, SSQ + (size_t)(l * 3 + (s == 6 ? 2 : 0)) * S * 16};
                pg8::gemm_phase<EpiSwiGLU, pg8::StaticOrder, true, true>(lds, g, So, E);
                {
                    const int full = (S / 256) * (2 * DFF / 256) % (int)gridDim.x;
                    if (l + 1 < NDEPTH && full != 0 && (int)blockIdx.x >= full)
                        convert_layer(p, l + 1, lds, s == 0 ? 0 : CV_CUT1, s == 0 ? CV_CUT1 : CV_CUT2, (int)blockIdx.x - full, (int)gridDim.x - full);
                    else if (l + 1 < NDEPTH && full == 0 && s == 6) convert_layer(p, l + 1, lds, 0, CV_CUT2, (int)blockIdx.x, (int)gridDim.x);
                }
            } else if (s == 1 || s == 7 || s == 5) {
                const bool ffn = (s != 5);
                pg8::Gemm g{ffn ? HID : MRG, W + (s == 1 ? O_WD0 : (s == 7 ? O_WD1 : O_WO)), S, DM, ffn ? DFF : DM}; pg8::StaticOrder So; So.init(S, DM, gridDim.x, blockIdx.x);
                const int nj = (s == 1) ? l * 3 + 1 : ((s == 5) ? l * 3 + 2 : l * 3 + 3);
                EpiResid E{(l == 0 && s == 1) ? p.x : p.out, p.out, XB, (nj < 12) ? SSQ + (size_t)nj * S * 16 : nullptr, ffn ? 0.5f : 1.0f};
                pg8::gemm_phase<EpiResid, pg8::StaticOrder, true, true>(lds, g, So, E);
            } else if (s == 2) {
                pg8::Gemm g{XB, W + O_WING, S, NPROJ + NGATE, DM}; pg8::StaticOrder So; So.init(S, NPROJ + NGATE, gridDim.x, blockIdx.x);
                EpiProjGate E{PROJ, G, p.b_gate + (size_t)l * NGATE, SSQ + (size_t)(l * 3 + 1) * S * 16, (bf16_t*)(p.ws + B_VT)};
                pg8::gemm_phase<EpiProjGate, pg8::StaticOrder, true, true>(lds, g, So, E);
                {
                    const int full = (S / 256) * ((NPROJ + NGATE) / 256) % (int)gridDim.x;
                    if (l + 1 < NDEPTH && full != 0 && (int)blockIdx.x >= full) convert_layer(p, l + 1, lds, CV_CUT2, CV_NITEMS, (int)blockIdx.x - full, (int)gridDim.x - full);
                    else if (l + 1 < NDEPTH && full == 0) convert_layer(p, l + 1, lds, CV_CUT2, CV_NITEMS, (int)blockIdx.x, (int)gridDim.x);
                }
            } else if (s == 3) {
                attn_phase(lds, p, l);
            } else if (s == 4) {
                for (int i = 0; i < 3; ++i) {
                    pg8::Gemm g{Y + (size_t)i * S * 512, W + O_WB + (size_t)i * E_WB, S, DM, 512}; pg8::StaticOrder So; So.init(S, DM, gridDim.x, blockIdx.x);
                    EpiBranch E{G, MRG, i * DM, i == 0};
                    pg8::gemm_phase<EpiBranch, pg8::StaticOrder, true, true>(lds, g, So, E);
                }
            }
        }
        if (step + 1 < p.step_hi) { if (step == p.step_lo) grid.sync(); else xcd_barrier(bar); }
    }
}

extern "C" void kernel_launch(void* const* d_in, const int* in_sizes, int n_in, void* d_out, int out_size, void* d_ws, size_t ws_size, hipStream_t stream) {
    static int grid = 0;
    if (grid == 0) {
        if (n_in != 16 || ws_size < B_END) { fprintf(stderr, "kernel_launch: unexpected n_in %d or ws_size %zu (< %zu)\n", n_in, ws_size, (size_t)B_END); grid = -1; return; }
        int dev = 0, cus = 0, per_cu = 0;
        hipGetDevice(&dev); hipDeviceGetAttribute(&cus, hipDeviceAttributeMultiprocessorCount, dev);
        if (hipFuncSetAttribute((const void*)mk_fwd, hipFuncAttributeMaxDynamicSharedMemorySize, LDS_BYTES) != hipSuccess) { fprintf(stderr, "kernel_launch: hipFuncSetAttribute failed\n"); grid = -1; return; }
        hipOccupancyMaxActiveBlocksPerMultiprocessor(&per_cu, (const void*)mk_fwd, 512, LDS_BYTES);
        if (per_cu < 1) { fprintf(stderr, "kernel_launch: occupancy query says %d blocks per CU\n", per_cu); per_cu = 1; }
        (void)hipGetLastError();
        grid = cus;
    }
    if (grid < 0) return;
    Params p{};
    p.x = (const float*)d_in[0]; p.w_in = (const float*)d_in[1]; p.w_branch = (const float*)d_in[2]; p.w_gate = (const float*)d_in[3]; p.b_gate = (const float*)d_in[4];
    p.w_o = (const float*)d_in[5]; p.norm_g = (const float*)d_in[6]; p.final_g = (const float*)d_in[7]; p.ffn_w_gate = (const float*)d_in[8]; p.ffn_w_up = (const float*)d_in[9];
    p.ffn_w_down = (const float*)d_in[10]; p.na_rpb = (const float*)d_in[11]; p.diff_lambda = (const float*)d_in[12]; p.diff_subln_g = (const float*)d_in[13]; p.gqa_sink = (const float*)d_in[14];
    p.rel_bias = (const float*)d_in[15]; p.out = (float*)d_out; p.ws = (unsigned char*)d_ws; p.step_lo = 0; p.step_hi = NSTEPS;
    if (hipMemsetAsync((char*)d_ws + B_BAR, 0, 16384, stream) != hipSuccess) { fprintf(stderr, "kernel_launch: hipMemsetAsync failed\n"); return; }
    void* args[] = {&p};
    hipError_t e = hipLaunchCooperativeKernel((const void*)mk_fwd, dim3(grid), dim3(512), args, LDS_BYTES, stream);
    if (e != hipSuccess) fprintf(stderr, "kernel_launch: cooperative launch failed: %s (grid %d)\n", hipGetErrorString(e), grid);
}
```

```cpp
#include <hip/hip_runtime.h>
#include <hip/hip_cooperative_groups.h>
#include <cstdio>
#include <cstdint>
namespace cg = cooperative_groups;
namespace pg8 {
#define PG8_LAS __attribute__((address_space(3)))
typedef unsigned short bf16_t;
typedef short bf16x8 __attribute__((ext_vector_type(8)));
typedef float f32x4 __attribute__((ext_vector_type(4)));
typedef unsigned u32x4 __attribute__((ext_vector_type(4)));
constexpr int BM = 256, BK = 64, HALF = 128, HTB = HALF * BK * 2  , STAGE_BYTES = 8 * HTB, NXCD = 8, WGM = 8;

__host__ __device__ __forceinline__ int lds_byte(int r, int c) { const int st = (r >> 4) * 2 + (c >> 5), rr = r & 15, cc = c & 31, ob = rr * 64 + cc * 2; return st * 1024 + (ob ^ (((ob >> 9) & 1) << 5)); }
__host__ __device__ __forceinline__ void stage_rc(int b, int& R, int& C) { const int st = b / 1024, sb = b % 1024, swz = sb ^ (((sb >> 9) & 1) << 5); R = (st >> 1) * 16 + swz / 64; C = (st & 1) * 32 + (swz % 64) / 2; }
__host__ __device__ __forceinline__ int perm32(int rho) { const int n = rho >> 4, i = rho & 15; return 8 * (i >> 2) + 4 * n + (i & 3); }

struct Unit { int pm, pn; };
struct Gemm { const bf16_t* A; const bf16_t* Bt; int M, N, K; };

struct StaticOrder {
    int nM, nN, nwg, G, c;
    __host__ __device__ void init(int M, int N, int G_, int c_) { nM = M / BM; nN = N / BM; nwg = nM * nN; G = G_; c = c_; }
    __host__ __device__ bool next(int i, Unit& u) const {
        const long L = (long)i * G + c; if (L >= nwg) return false;
        int wgid = (int)L; { const int q = nwg / NXCD, r = nwg % NXCD, xcd = wgid % NXCD, off = wgid / NXCD; wgid = (xcd < r ? xcd * (q + 1) : r * (q + 1) + (xcd - r) * q) + off; }
        const int nig = WGM * nN, gid = wgid / nig, fm = gid * WGM, gsz = (nM - fm) < WGM ? (nM - fm) : WGM;
        u.pm = fm + ((wgid % nig) % gsz); u.pn = (wgid % nig) / gsz; return true;
    }
    __device__ __forceinline__ void a_ready(const Unit&) const {}
    __device__ __forceinline__ void done(const Unit&) const {}
};

typedef float f32x2c __attribute__((ext_vector_type(2))); typedef __bf16 bf16x2c __attribute__((ext_vector_type(2)));
__device__ __forceinline__ unsigned cvt_pk_bf16(float lo, float hi) { f32x2c v = {lo, hi}; bf16x2c b = __builtin_convertvector(v, bf16x2c); return __builtin_bit_cast(unsigned, b); }
__device__ __forceinline__ int pg8_opaque_tid() { int t = threadIdx.x; asm volatile("" : "+v"(t)); return t; }
template <class Epi, class Sched, bool ALIGN_EPI = false, bool SP2 = false>
__device__ __forceinline__ void gemm_phase(PG8_LAS unsigned char* lds, const Gemm g, const Sched& S, const Epi& E) {
    const int tid = pg8_opaque_tid(), wid = __builtin_amdgcn_readfirstlane(tid >> 6), lane = tid & 63, wr = wid >> 2, wc = wid & 3, fr = lane & 15, fq = lane >> 4;
    const int K = g.K, nt = K / BK;
    unsigned voffA[2], voffB[2];
#pragma unroll
    for (int i = 0; i < 2; ++i) { int R, C; stage_rc(tid * 16 + i * 8192, R, C); const int Rb = Epi::PERM ? ((R & ~31) + perm32(R & 31)) : R;
        voffA[i] = (unsigned)(R * K + C) * 2u; voffB[i] = (unsigned)(Rb * K + C) * 2u; }
    const size_t kstep = (size_t)(BK * 2);
    const size_t hstep = (size_t)HALF * K * 2;
    const size_t tstep = 2 * hstep;
    const unsigned ldsw = (unsigned)wid * 1024u;
    const int aoff = lds_byte(wr * 64 + fr, fq * 8), boff = lds_byte(wc * 32 + fr, fq * 8);
#define PG8_SA(b, h) (((b) * 2 + (h)) * HTB)
#define PG8_SB(b, h) ((4 + (b) * 2 + (h)) * HTB)
#define PG8_STAGE(bufoff, gbase, voff) do { _Pragma("unroll") for (int _i = 0; _i < 2; ++_i) \
        __builtin_amdgcn_global_load_lds((const unsigned*)((const char*)(gbase) + (voff)[_i]), (PG8_LAS unsigned*)(lds + (bufoff) + ldsw + _i * 8192), 16, 0, 0); } while (0)
#define PG8_LDA(dst, b, h) do { _Pragma("unroll") for (int m = 0; m < 4; ++m) _Pragma("unroll") for (int k = 0; k < 2; ++k) dst[m][k] = *(const PG8_LAS bf16x8*)(lds + PG8_SA(b, h) + aoff + m * 2048 + k * 1024); } while (0)
#define PG8_LDB(dst, b, h) do { _Pragma("unroll") for (int n = 0; n < 2; ++n) _Pragma("unroll") for (int k = 0; k < 2; ++k) dst[n][k] = *(const PG8_LAS bf16x8*)(lds + PG8_SB(b, h) + boff + n * 2048 + k * 1024); } while (0)
#define PG8_MMA(ai, bj, At, Bt) do { __builtin_amdgcn_s_setprio(1); _Pragma("unroll") for (int m = 0; m < 4; ++m) _Pragma("unroll") for (int n = 0; n < 2; ++n) _Pragma("unroll") for (int k = 0; k < 2; ++k) \
        acc[ai][bj][m][n] = __builtin_amdgcn_mfma_f32_16x16x32_bf16(Bt[n][k], At[m][k], acc[ai][bj][m][n], 0, 0, 0); __builtin_amdgcn_s_setprio(0); } while (0)
#define PG8_WAIT_V(n) asm volatile("s_waitcnt vmcnt(" #n ")" ::: "memory")
#define PG8_WAIT_L(n) asm volatile("s_waitcnt lgkmcnt(" #n ")" ::: "memory")
#define PG8_BAR __builtin_amdgcn_s_barrier()
#define PG8_SCHED __builtin_amdgcn_sched_barrier(0)
    Unit cur, nxt; int ui = 0;
    if (!S.next(0, cur)) return;
    f32x4 acc[2][2][4][2];
#pragma unroll
    for (int a = 0; a < 2; ++a)
#pragma unroll
        for (int b = 0; b < 2; ++b)
#pragma unroll
            for (int m = 0; m < 4; ++m)
#pragma unroll
                for (int n = 0; n < 2; ++n) acc[a][b][m][n] = (f32x4){0.f, 0.f, 0.f, 0.f};
    bf16x8 At[4][2], B0[2][2], B1[2][2];
    const char* cA = (const char*)g.A + (size_t)cur.pm * tstep; const char* cB = (const char*)g.Bt + (size_t)cur.pn * tstep;
    S.a_ready(cur);
    if constexpr (SP2) {
        PG8_STAGE(PG8_SB(0, 0), cB, voffB); PG8_STAGE(PG8_SB(0, 1), cB + hstep, voffB); PG8_STAGE(PG8_SA(0, 0), cA, voffA); PG8_STAGE(PG8_SA(0, 1), cA + hstep, voffA);
        if (wr == 1) PG8_BAR;
        PG8_WAIT_V(2); PG8_BAR;
        PG8_STAGE(PG8_SB(1, 0), cB + kstep, voffB); PG8_STAGE(PG8_SA(1, 0), cA + kstep, voffA); PG8_STAGE(PG8_SB(1, 1), cB + hstep + kstep, voffB);
        PG8_WAIT_V(6); PG8_BAR;
    } else {
        PG8_STAGE(PG8_SB(0, 0), cB, voffB); PG8_STAGE(PG8_SA(0, 0), cA, voffA); PG8_STAGE(PG8_SB(0, 1), cB + hstep, voffB); PG8_STAGE(PG8_SA(0, 1), cA + hstep, voffA);
        if (wr == 1) PG8_BAR;
        PG8_WAIT_V(4); PG8_BAR;
        PG8_STAGE(PG8_SB(1, 0), cB + kstep, voffB); PG8_STAGE(PG8_SA(1, 0), cA + kstep, voffA); PG8_STAGE(PG8_SB(1, 1), cB + hstep + kstep, voffB);
        PG8_WAIT_V(6); PG8_BAR;
    }
    for (;;) {
        const bool has_next = S.next(ui + 1, nxt);
        const char* nA = has_next ? (const char*)g.A + (size_t)nxt.pm * tstep : cA; const char* nB = has_next ? (const char*)g.Bt + (size_t)nxt.pn * tstep : cB;
        for (int t = 0; t < nt; t += 2) {
            const bool last = (t == nt - 2);
            const char* a1 = cA + (size_t)(t + 1) * kstep;
            const char* a2 = last ? nA : cA + (size_t)(t + 2) * kstep; const char* b2 = last ? nB : cB + (size_t)(t + 2) * kstep;
            const char* a3 = a2 + kstep; const char* b3 = b2 + kstep;
            if (last && has_next) S.a_ready(nxt);
            if constexpr (SP2) {
            PG8_LDB(B0, 0, 0); PG8_LDB(B1, 0, 1); PG8_SCHED; PG8_LDA(At, 0, 0); PG8_STAGE(PG8_SA(1, 1), a1 + hstep, voffA);
            PG8_WAIT_V(8); PG8_WAIT_L(0); PG8_BAR; PG8_MMA(0, 0, At, B0); PG8_MMA(0, 1, At, B1); PG8_BAR; PG8_SCHED;
            PG8_LDA(At, 0, 1); PG8_STAGE(PG8_SB(0, 0), b2, voffB); PG8_STAGE(PG8_SB(0, 1), b2 + hstep, voffB); PG8_STAGE(PG8_SA(0, 0), a2, voffA);
            PG8_WAIT_V(8); PG8_WAIT_L(0); PG8_BAR; PG8_MMA(1, 0, At, B0); PG8_MMA(1, 1, At, B1); PG8_BAR; PG8_SCHED;
            PG8_LDB(B0, 1, 0); PG8_LDB(B1, 1, 1); PG8_SCHED; PG8_LDA(At, 1, 0); PG8_STAGE(PG8_SA(0, 1), a2 + hstep, voffA);
            PG8_WAIT_V(8); PG8_WAIT_L(0); PG8_BAR; PG8_MMA(0, 0, At, B0); PG8_MMA(0, 1, At, B1); PG8_BAR; PG8_SCHED;
            PG8_LDA(At, 1, 1); PG8_STAGE(PG8_SB(1, 0), b3, voffB); PG8_STAGE(PG8_SB(1, 1), b3 + hstep, voffB); PG8_STAGE(PG8_SA(1, 0), a3, voffA);
            PG8_WAIT_V(8); PG8_WAIT_L(0); PG8_BAR; PG8_MMA(1, 0, At, B0); PG8_MMA(1, 1, At, B1); PG8_BAR; PG8_SCHED;
            } else {
            PG8_LDB(B0, 0, 0); PG8_SCHED; PG8_LDA(At, 0, 0); PG8_STAGE(PG8_SA(1, 1), a1 + hstep, voffA);
            PG8_WAIT_L(8); PG8_BAR; PG8_WAIT_L(0); PG8_MMA(0, 0, At, B0); PG8_BAR; PG8_SCHED;
            PG8_LDB(B1, 0, 1); PG8_STAGE(PG8_SB(0, 0), b2, voffB);
            PG8_BAR; PG8_WAIT_L(0); PG8_MMA(0, 1, At, B1); PG8_BAR;
            PG8_LDA(At, 0, 1); PG8_STAGE(PG8_SA(0, 0), a2, voffA);
            PG8_BAR; PG8_WAIT_L(0); PG8_MMA(1, 0, At, B0); PG8_BAR; PG8_SCHED;
            PG8_STAGE(PG8_SB(0, 1), b2 + hstep, voffB);
            PG8_WAIT_V(6); PG8_BAR; PG8_MMA(1, 1, At, B1); PG8_BAR;
            PG8_LDB(B0, 1, 0); PG8_SCHED; PG8_LDA(At, 1, 0); PG8_STAGE(PG8_SA(0, 1), a2 + hstep, voffA);
            PG8_WAIT_L(8); PG8_BAR; PG8_WAIT_L(0); PG8_MMA(0, 0, At, B0); PG8_BAR; PG8_SCHED;
            PG8_LDB(B1, 1, 1); PG8_STAGE(PG8_SB(1, 0), b3, voffB);
            PG8_BAR; PG8_WAIT_L(0); PG8_MMA(0, 1, At, B1); PG8_BAR;
            PG8_LDA(At, 1, 1); PG8_STAGE(PG8_SA(1, 0), a3, voffA);
            PG8_BAR; PG8_WAIT_L(0); PG8_MMA(1, 0, At, B0); PG8_BAR; PG8_SCHED;
            PG8_STAGE(PG8_SB(1, 1), b3 + hstep, voffB);
            PG8_WAIT_V(6); PG8_BAR; PG8_MMA(1, 1, At, B1); PG8_BAR;
            }
        }
        if constexpr (ALIGN_EPI) { if (wr == 0) PG8_BAR; }
        if constexpr (!Epi::AFTER_DRAIN) { E(acc, cur, wr, wc, fr, fq); S.done(cur); }
        if (!has_next) break;
#pragma unroll
        for (int a = 0; a < 2; ++a)
#pragma unroll
            for (int b = 0; b < 2; ++b)
#pragma unroll
                for (int m = 0; m < 4; ++m)
#pragma unroll
                    for (int n = 0; n < 2; ++n) acc[a][b][m][n] = (f32x4){0.f, 0.f, 0.f, 0.f};
        cur = nxt; cA = nA; cB = nB; ++ui;
        if constexpr (ALIGN_EPI) { if (wr == 1) PG8_BAR; }
    }
    PG8_WAIT_V(0);
    if constexpr (!ALIGN_EPI) { if (wr == 0) PG8_BAR; }
    PG8_BAR;
    if constexpr (Epi::AFTER_DRAIN) { E.fused(acc, cur, wr, wc, fr, fq, lds, wid, lane); S.done(cur); }
#undef PG8_SA
#undef PG8_SB
#undef PG8_STAGE
#undef PG8_LDA
#undef PG8_LDB
#undef PG8_MMA
#undef PG8_WAIT_V
#undef PG8_WAIT_L
#undef PG8_BAR
#undef PG8_SCHED
}
}

#define LAS __attribute__((address_space(3)))
typedef unsigned short bf16_t;
typedef short bf16x8 __attribute__((ext_vector_type(8)));
typedef short s16x4 __attribute__((ext_vector_type(4)));
typedef float f32x4 __attribute__((ext_vector_type(4)));
typedef float f32x16 __attribute__((ext_vector_type(16)));
typedef unsigned u32x4 __attribute__((ext_vector_type(4)));
typedef unsigned u32x2 __attribute__((ext_vector_type(2)));

constexpr int S = 16384, DM = 1024, DFF = 2816, NPROJ = 3840, NGATE = 3072, NDEPTH = 4;
constexpr int NVT = 1152;
constexpr float LOG2E = 1.4426950408889634f;
constexpr float QSCALE = 0.125f * LOG2E;
constexpr float NEGBIG = -1e30f;
constexpr int NSTEP_PER_LAYER = 8, NSTEPS = 1 + NDEPTH * NSTEP_PER_LAYER + 1;

struct Params {
    const float *x, *w_in, *w_branch, *w_gate, *b_gate, *w_o, *norm_g, *final_g, *ffn_w_gate, *ffn_w_up, *ffn_w_down, *na_rpb, *diff_lambda, *diff_subln_g, *gqa_sink, *rel_bias;
    float* out; unsigned char* ws; int step_lo, step_hi;
};

constexpr size_t E_WGU = (size_t)2 * DFF * DM, E_WD = (size_t)DM * DFF, E_WING = (size_t)(NPROJ + NGATE) * DM, E_WB = (size_t)DM * 512, E_WO = (size_t)DM * DM;
constexpr size_t O_WGU0 = 0, O_WD0 = O_WGU0 + E_WGU, O_WING = O_WD0 + E_WD, O_WB = O_WING + E_WING, O_WO = O_WB + 3 * E_WB, O_WGU1 = O_WO + E_WO, O_WD1 = O_WGU1 + E_WGU, E_WTOT = O_WD1 + E_WD;
constexpr size_t B_W = 0, B_XB = B_W + 2 * E_WTOT * 2, B_PROJ = B_XB + (size_t)S * DM * 2, B_G = B_PROJ + (size_t)S * NPROJ * 2, B_Y = B_G + (size_t)S * NGATE * 2,
                 B_VT = B_Y + 3 * (size_t)S * 512 * 2, B_SSQ = B_VT + (size_t)NVT * S * 2, B_MRG = B_PROJ  , B_BAR = B_SSQ + (size_t)12 * S * 16 * 4, B_END = B_BAR + 16384;
constexpr int LDS_BYTES = 131072 + 1024;

__device__ __forceinline__ unsigned pk2(float lo, float hi) { return pg8::cvt_pk_bf16(lo, hi); }
__device__ __forceinline__ float bflo(unsigned w) { return __uint_as_float(w << 16); }
__device__ __forceinline__ float bfhi(unsigned w) { return __uint_as_float(w & 0xffff0000u); }
__device__ __forceinline__ float fast_exp2(float x) { return __builtin_amdgcn_exp2f(x); }
__device__ __forceinline__ float fast_rcp(float x) { return __builtin_amdgcn_rcpf(x); }
__device__ __forceinline__ float wave_sum(float v) {
#pragma unroll
    for (int o = 1; o < 64; o <<= 1) v += __shfl_xor(v, o);
    return v;
}
__device__ __forceinline__ float xhalf_sum(float v) { auto rr = __builtin_amdgcn_permlane32_swap(__float_as_uint(v), __float_as_uint(v), false, false); return __uint_as_float(rr[0]) + __uint_as_float(rr[1]); }
__device__ __forceinline__ float xhalf_max(float v) { auto rr = __builtin_amdgcn_permlane32_swap(__float_as_uint(v), __float_as_uint(v), false, false); return fmaxf(__uint_as_float(rr[0]), __uint_as_float(rr[1])); }

__device__ __forceinline__ float rstd_of(const float* ssq, int row) {
    const f32x4* q = (const f32x4*)(ssq + (size_t)row * 16); const f32x4 a = q[0], b = q[1], c = q[2], d = q[3];
    const float t = (((a.x + a.y) + (a.z + a.w)) + ((b.x + b.y) + (b.z + b.w))) + (((c.x + c.y) + (c.z + c.w)) + ((d.x + d.y) + (d.z + d.w)));
    return 1.0f / sqrtf(t * (1.0f / DM) + 1e-6f); }
struct EpiSwiGLU {
    static constexpr bool PERM = true, AFTER_DRAIN = false;
    bf16_t* O; const float* ssq;
    __device__ __forceinline__ void operator()(const pg8::f32x4 (&acc)[2][2][4][2], const pg8::Unit& u, int wr, int wc, int fr, int fq) const {
        const int row0 = u.pm * 256 + wr * 64 + fr, col0 = u.pn * 128 + wc * 32 + 8 * fq;
#pragma unroll
        for (int ai = 0; ai < 2; ++ai)
#pragma unroll
            for (int m = 0; m < 4; ++m) {
                const int row = row0 + ai * 128 + m * 16; const float rs = rstd_of(ssq, row);
                bf16_t* dst = O + (size_t)row * DFF + col0;
                float v[8];
#pragma unroll
                for (int n = 0; n < 2; ++n)
#pragma unroll
                    for (int j = 0; j < 4; ++j) { const float g = acc[ai][0][m][n][j] * rs, uu = acc[ai][1][m][n][j] * rs; v[n * 4 + j] = g * fast_rcp(1.0f + fast_exp2(-g * LOG2E)) * uu; }
                u32x4 w; w.x = pk2(v[0], v[1]); w.y = pk2(v[2], v[3]); w.z = pk2(v[4], v[5]); w.w = pk2(v[6], v[7]);
                *(u32x4*)dst = w;
            }
    }
};
struct EpiResid {
    static constexpr bool PERM = true, AFTER_DRAIN = false;
    const float* base; float* out; bf16_t* xb; float* ssq; float alpha;
    __device__ __forceinline__ void operator()(const pg8::f32x4 (&acc)[2][2][4][2], const pg8::Unit& u, int wr, int wc, int fr, int fq) const {
        const int row0 = u.pm * 256 + wr * 64 + fr, col0 = u.pn * 256 + wc * 32 + 8 * fq;
#pragma unroll
        for (int ai = 0; ai < 2; ++ai) {
            f32x4 bv[4][2][2];
#pragma unroll
            for (int m = 0; m < 4; ++m)
#pragma unroll
                for (int bj = 0; bj < 2; ++bj) { const size_t off = (size_t)(row0 + ai * 128 + m * 16) * DM + col0 + bj * 128; bv[m][bj][0] = *(const f32x4*)(base + off); bv[m][bj][1] = *(const f32x4*)(base + off + 4); }
#pragma unroll
            for (int m = 0; m < 4; ++m) {
                const int row = row0 + ai * 128 + m * 16; float ss = 0.f;
#pragma unroll
                for (int bj = 0; bj < 2; ++bj) {
                    const size_t off = (size_t)row * DM + col0 + bj * 128;
                    const f32x4 x0 = bv[m][bj][0] + acc[ai][bj][m][0] * alpha, x1 = bv[m][bj][1] + acc[ai][bj][m][1] * alpha;
                    *(f32x4*)(out + off) = x0; *(f32x4*)(out + off + 4) = x1;
                    u32x4 w; w.x = pk2(x0[0], x0[1]); w.y = pk2(x0[2], x0[3]); w.z = pk2(x1[0], x1[1]); w.w = pk2(x1[2], x1[3]);
                    *(u32x4*)(xb + off) = w;
                    ss += ((x0[0] * x0[0] + x0[1] * x0[1]) + (x0[2] * x0[2] + x0[3] * x0[3])) + ((x1[0] * x1[0] + x1[1] * x1[1]) + (x1[2] * x1[2] + x1[3] * x1[3]));
                }
                ss += __shfl_xor(ss, 16); ss += __shfl_xor(ss, 32);
                if (ssq && fq == 0) ssq[(size_t)row * 16 + u.pn * 4 + wc] = ss;
            }
            asm volatile("" ::: "memory");
        }
    }
};
struct EpiProjGate {
    static constexpr bool PERM = true, AFTER_DRAIN = false;
    bf16_t* proj; bf16_t* G; const float* bg; const float* ssq; bf16_t* vt;
    __device__ __forceinline__ void operator()(const pg8::f32x4 (&acc)[2][2][4][2], const pg8::Unit& u, int wr, int wc, int fr, int fq) const {
        const int row0 = u.pm * 256 + wr * 64 + fr;
        if (u.pn < 15) {
            const float sc = ((u.pn % 6) < 2) ? QSCALE : 1.0f;
            const int col0 = u.pn * 256 + wc * 32 + 8 * fq;
            const bool vt_all = (u.pn == 4) | (u.pn == 5) | (u.pn == 10) | (u.pn == 11), vt_half = (u.pn == 14);
            const int vrow0 = (u.pn <= 5 ? (u.pn - 4) * 256 : (u.pn <= 11 ? 512 + (u.pn - 10) * 256 : 1024 - 128)) + wc * 32 + 8 * fq;
#pragma unroll
            for (int ai = 0; ai < 2; ++ai)
#pragma unroll
                for (int m = 0; m < 4; ++m) {
                    const int row = row0 + ai * 128 + m * 16; const float rs = rstd_of(ssq, row) * sc;
#pragma unroll
                    for (int bj = 0; bj < 2; ++bj) {
                        const pg8::f32x4 v0 = acc[ai][bj][m][0] * rs, v1 = acc[ai][bj][m][1] * rs;
                        u32x4 w; w.x = pk2(v0[0], v0[1]); w.y = pk2(v0[2], v0[3]); w.z = pk2(v1[0], v1[1]); w.w = pk2(v1[2], v1[3]);
                        if (vt_all || (vt_half && bj == 1)) {
                            bf16_t* vp = vt + (size_t)(vrow0 + bj * 128) * S + row;
                            vp[0 * (size_t)S] = (bf16_t)(w.x & 0xffffu); vp[1 * (size_t)S] = (bf16_t)(w.x >> 16); vp[2 * (size_t)S] = (bf16_t)(w.y & 0xffffu); vp[3 * (size_t)S] = (bf16_t)(w.y >> 16);
                            vp[4 * (size_t)S] = (bf16_t)(w.z & 0xffffu); vp[5 * (size_t)S] = (bf16_t)(w.z >> 16); vp[6 * (size_t)S] = (bf16_t)(w.w & 0xffffu); vp[7 * (size_t)S] = (bf16_t)(w.w >> 16);
                        } else {
                            *(u32x4*)(proj + (size_t)row * NPROJ + col0 + bj * 128) = w;
                        }
                    }
                }
        } else {
            const int col0 = (u.pn - 15) * 256 + wc * 32 + 8 * fq;
            f32x4 bb[2][2];
#pragma unroll
            for (int bj = 0; bj < 2; ++bj) { bb[bj][0] = *(const f32x4*)(bg + col0 + bj * 128); bb[bj][1] = *(const f32x4*)(bg + col0 + bj * 128 + 4); }
#pragma unroll
            for (int ai = 0; ai < 2; ++ai)
#pragma unroll
                for (int m = 0; m < 4; ++m) {
                    const int row = row0 + ai * 128 + m * 16; const float rs = rstd_of(ssq, row);
#pragma unroll
                    for (int bj = 0; bj < 2; ++bj) {
                        float v[8];
#pragma unroll
                        for (int j = 0; j < 4; ++j) { v[j] = fast_rcp(1.0f + fast_exp2(-(acc[ai][bj][m][0][j] * rs + bb[bj][0][j]) * LOG2E)); v[4 + j] = fast_rcp(1.0f + fast_exp2(-(acc[ai][bj][m][1][j] * rs + bb[bj][1][j]) * LOG2E)); }
                        u32x4 w; w.x = pk2(v[0], v[1]); w.y = pk2(v[2], v[3]); w.z = pk2(v[4], v[5]); w.w = pk2(v[6], v[7]);
                        *(u32x4*)(G + (size_t)row * NGATE + col0 + bj * 128) = w;
                    }
                }
        }
    }
};
struct EpiBranch {
    static constexpr bool PERM = true, AFTER_DRAIN = false;
    const bf16_t* G; bf16_t* mrg; int coloff; bool first;
    __device__ __forceinline__ void operator()(const pg8::f32x4 (&acc)[2][2][4][2], const pg8::Unit& u, int wr, int wc, int fr, int fq) const {
        const int row0 = u.pm * 256 + wr * 64 + fr, col0 = u.pn * 256 + wc * 32 + 8 * fq;
#pragma unroll
        for (int ai = 0; ai < 2; ++ai) {
            u32x4 gv[4][2], ov[4][2];
#pragma unroll
            for (int m = 0; m < 4; ++m)
#pragma unroll
                for (int bj = 0; bj < 2; ++bj) {
                    const int row = row0 + ai * 128 + m * 16;
                    gv[m][bj] = *(const u32x4*)(G + (size_t)row * NGATE + coloff + col0 + bj * 128);
                    ov[m][bj] = (u32x4){0u, 0u, 0u, 0u}; if (!first) ov[m][bj] = *(const u32x4*)(mrg + (size_t)row * DM + col0 + bj * 128);
                }
#pragma unroll
            for (int m = 0; m < 4; ++m)
#pragma unroll
                for (int bj = 0; bj < 2; ++bj) {
                    const int row = row0 + ai * 128 + m * 16;
                    const u32x4 g = gv[m][bj], o = ov[m][bj]; const pg8::f32x4 a0 = acc[ai][bj][m][0], a1 = acc[ai][bj][m][1];
                    u32x4 w; w.x = pk2(bflo(o.x) + bflo(g.x) * a0[0], bfhi(o.x) + bfhi(g.x) * a0[1]); w.y = pk2(bflo(o.y) + bflo(g.y) * a0[2], bfhi(o.y) + bfhi(g.y) * a0[3]);
                    w.z = pk2(bflo(o.z) + bflo(g.z) * a1[0], bfhi(o.z) + bfhi(g.z) * a1[1]); w.w = pk2(bflo(o.w) + bflo(g.w) * a1[2], bfhi(o.w) + bfhi(g.w) * a1[3]);
                    *(u32x4*)(mrg + (size_t)row * DM + col0 + bj * 128) = w;
                }
            asm volatile("" ::: "memory");
        }
    }
};

__device__ __forceinline__ void transpose_tile(const float* src, int srcN, const float* gk, bf16_t* dst, int dstK, LAS float* scr, int lane) {
    float tv[32];
#pragma unroll
    for (int i = 0; i < 32; ++i) tv[i] = src[(size_t)(2 * i + (lane >> 5)) * srcN + (lane & 31)];
    if (gk) {
#pragma unroll
        for (int i = 0; i < 32; ++i) tv[i] *= gk[2 * i + (lane >> 5)];
    }
#pragma unroll
    for (int i = 0; i < 32; ++i) scr[(2 * i + (lane >> 5)) * 33 + (lane & 31)] = tv[i];
    asm volatile("s_waitcnt lgkmcnt(0)" ::: "memory");
    const int c = lane & 7;
#pragma unroll
    for (int j = 0; j < 4; ++j) {
        const int n = (lane >> 3) + 8 * j; const LAS float* s = scr + (8 * c) * 33 + n;
        u32x4 o; o.x = pk2(s[0 * 33], s[1 * 33]); o.y = pk2(s[2 * 33], s[3 * 33]); o.z = pk2(s[4 * 33], s[5 * 33]); o.w = pk2(s[6 * 33], s[7 * 33]);
        *(u32x4*)(dst + (size_t)n * dstK + 8 * c) = o;
    }
    asm volatile("s_waitcnt lgkmcnt(0)" ::: "memory");
}
constexpr int CV_I_GU = (2 * DFF / 32) * (DM / 64), CV_I_D = (DM / 32) * (DFF / 64), CV_I_ING = ((NPROJ + NGATE) / 32) * (DM / 64), CV_I_B = (DM / 32) * (512 / 64), CV_I_O = (DM / 32) * (DM / 64);
constexpr int CV_NITEMS = 2 * CV_I_GU + 2 * CV_I_D + CV_I_ING + 3 * CV_I_B + CV_I_O;
constexpr int CV_CUT1 = (CV_NITEMS * 2) / 5, CV_CUT2 = (CV_NITEMS * 4) / 5;
__device__ __forceinline__ void convert_layer(const Params& p, int l, LAS unsigned char* lds, int it_lo, int it_hi, int worker, int nworkers) {
    const int tid = pg8::pg8_opaque_tid(), lane = tid & 63, wid = __builtin_amdgcn_readfirstlane(tid >> 6);
    LAS float* scr = (LAS float*)(lds + wid * 8448);
    bf16_t* W = (bf16_t*)(p.ws + B_W) + (size_t)(l & 1) * E_WTOT;
    const float* ng = p.norm_g + (size_t)l * 3 * DM;
    constexpr int I_GU = CV_I_GU, I_D = CV_I_D, I_ING = CV_I_ING, I_B = CV_I_B;
    for (int it = it_lo + worker * 8 + wid; it < it_hi; it += nworkers * 8) {
        int r = it;
        if (r < 2 * I_GU) {
            const int f = r / I_GU; r -= f * I_GU; const int nb = r / (DM / 64), kb = r % (DM / 64), n0 = nb * 32, k0 = kb * 64;
            const int pn = n0 >> 8, w = n0 & 255; const float* src = ((w < 128) ? p.ffn_w_gate : p.ffn_w_up) + (size_t)(l * 2 + f) * DM * DFF;
            transpose_tile(src + (size_t)k0 * DFF + pn * 128 + (w & 127), DFF, ng + (f ? 2 : 0) * DM + k0, W + (f ? O_WGU1 : O_WGU0) + (size_t)n0 * DM + k0, DM, scr, lane); continue; }
        r -= 2 * I_GU;
        if (r < 2 * I_D) {
            const int f = r / I_D; r -= f * I_D; const int nb = r / (DFF / 64), kb = r % (DFF / 64), n0 = nb * 32, k0 = kb * 64;
            const float* src = p.ffn_w_down + (size_t)(l * 2 + f) * DFF * DM;
            transpose_tile(src + (size_t)k0 * DM + n0, DM, nullptr, W + (f ? O_WD1 : O_WD0) + (size_t)n0 * DFF + k0, DFF, scr, lane); continue; }
        r -= 2 * I_D;
        if (r < I_ING) {
            const int nb = r / (DM / 64), kb = r % (DM / 64), n0 = nb * 32, k0 = kb * 64;
            if (n0 < NPROJ) transpose_tile(p.w_in + (size_t)l * DM * NPROJ + (size_t)k0 * NPROJ + n0, NPROJ, ng + DM + k0, W + O_WING + (size_t)n0 * DM + k0, DM, scr, lane);
            else transpose_tile(p.w_gate + (size_t)l * DM * NGATE + (size_t)k0 * NGATE + (n0 - NPROJ), NGATE, ng + DM + k0, W + O_WING + (size_t)n0 * DM + k0, DM, scr, lane);
            continue; }
        r -= I_ING;
        if (r < 3 * I_B) {
            const int i = r / I_B; r -= i * I_B; const int nb = r / 8, kb = r % 8, n0 = nb * 32, k0 = kb * 64;
            transpose_tile(p.w_branch + (size_t)(l * 3 + i) * 512 * DM + (size_t)k0 * DM + n0, DM, nullptr, W + O_WB + (size_t)i * E_WB + (size_t)n0 * 512 + k0, 512, scr, lane); continue; }
        r -= 3 * I_B;
        {
            const int nb = r / (DM / 64), kb = r % (DM / 64), n0 = nb * 32, k0 = kb * 64;
            transpose_tile(p.w_o + (size_t)l * DM * DM + (size_t)k0 * DM + n0, DM, nullptr, W + O_WO + (size_t)n0 * DM + k0, DM, scr, lane); }
    }
}

__device__ __forceinline__ void prologue_rows(const float* x, bf16_t* xb, float* ssq) {
    const int tid = pg8::pg8_opaque_tid(), lane = tid & 63, wid = __builtin_amdgcn_readfirstlane(tid >> 6);
    const int gw = blockIdx.x * 8 + wid, NGW = gridDim.x * 8;
    for (int row0 = gw; row0 < S; row0 += 2 * NGW) {
        f32x4 v[2][4];
#pragma unroll
        for (int h = 0; h < 2; ++h)
#pragma unroll
            for (int j = 0; j < 4; ++j) v[h][j] = *((const f32x4*)(x + (size_t)(row0 + h * NGW) * DM) + lane + 64 * j);
#pragma unroll
        for (int h = 0; h < 2; ++h) {
            const int row = row0 + h * NGW; u32x2* o = (u32x2*)(xb + (size_t)row * DM) + lane; float ss = 0.f;
#pragma unroll
            for (int j = 0; j < 4; ++j) { const f32x4 t = v[h][j]; ss += (t.x * t.x + t.y * t.y) + (t.z * t.z + t.w * t.w); u32x2 w; w.x = pk2(t.x, t.y); w.y = pk2(t.z, t.w); o[64 * j] = w; }
            ss = wave_sum(ss);
            if (lane < 16) ssq[(size_t)row * 16 + lane] = (lane == 0) ? ss : 0.f;
        }
    }
}
__device__ __forceinline__ void final_norm(float* x, const float* g) {
    const int tid = pg8::pg8_opaque_tid(), lane = tid & 63, wid = __builtin_amdgcn_readfirstlane(tid >> 6);
    const int gw = blockIdx.x * 8 + wid, NGW = gridDim.x * 8;
    f32x4 gv[4];
#pragma unroll
    for (int j = 0; j < 4; ++j) gv[j] = *((const f32x4*)g + lane + 64 * j);
    for (int row0 = gw; row0 < S; row0 += 2 * NGW) {
        f32x4 v[2][4];
#pragma unroll
        for (int h = 0; h < 2; ++h)
#pragma unroll
            for (int j = 0; j < 4; ++j) v[h][j] = *((const f32x4*)(x + (size_t)(row0 + h * NGW) * DM) + lane + 64 * j);
#pragma unroll
        for (int h = 0; h < 2; ++h) {
            f32x4* xr = (f32x4*)(x + (size_t)(row0 + h * NGW) * DM) + lane; float ss = 0.f;
#pragma unroll
            for (int j = 0; j < 4; ++j) ss += (v[h][j].x * v[h][j].x + v[h][j].y * v[h][j].y) + (v[h][j].z * v[h][j].z + v[h][j].w * v[h][j].w);
            const float rstd = 1.0f / sqrtf(wave_sum(ss) * (1.0f / DM) + 1e-6f);
#pragma unroll
            for (int j = 0; j < 4; ++j) xr[64 * j] = v[h][j] * rstd * gv[j];
        }
    }
}

__device__ __forceinline__ float max2m(float a, float b) { return __builtin_amdgcn_fmed3f(a, b, __builtin_inff()); }
__device__ __forceinline__ float max3f(float a, float b, float c) { return max2m(max2m(a, b), c); }
__device__ __forceinline__ int crow(int r, int hi) { return (r & 3) + 8 * (r >> 2) + 4 * hi; }
__device__ __forceinline__ int t5_bucket(int rel) {
    const int n = rel < 0 ? -rel : rel; int b;
    if (n < 8) b = n; else if (n < 12) b = 8; else if (n < 16) b = 9; else if (n < 23) b = 10; else if (n < 32) b = 11; else if (n < 46) b = 12; else if (n < 64) b = 13; else if (n < 91) b = 14; else b = 15;
    return b + (rel > 0 ? 16 : 0);
}
typedef short v4i16_t __attribute__((ext_vector_type(4)));
__device__ __forceinline__ s16x4 tr_read(const LAS unsigned char* p) { return __builtin_bit_cast(s16x4, __builtin_amdgcn_ds_read_tr16_b64_v4i16((LAS v4i16_t*)p)); }

template <int MODE, bool FROZEN = false>
__device__ __forceinline__ bool attn_unit(LAS unsigned char* lds, const Params& p, int l, int ua, int ub) {
    constexpr int KW = (MODE == 1) ? 128 : 64, DV = (MODE == 1) ? 128 : 64, NB = DV / 32;
    constexpr int KPB = KW * 2 + 16, VTP = 144, KBUF = 64 * KPB, VBUF = DV * VTP;
    constexpr int OFF_K = 0, OFF_V = 2 * KBUF, OFF_LUT = 2 * KBUF + 2 * VBUF;
    constexpr int KCH = KW / 8, NKC = 64 * KCH / 512, NVC = DV * 8 / 512;
    const int tid = pg8::pg8_opaque_tid(), lane = tid & 63, wid = __builtin_amdgcn_readfirstlane(tid >> 6), r32 = lane & 31, hi = lane >> 5;
    const bf16_t* proj = (const bf16_t*)(p.ws + B_PROJ);
    const bf16_t* vtg = (const bf16_t*)(p.ws + B_VT);
    LAS float* lut = (LAS float*)(lds + OFF_LUT);

    int qtok0, qcol, kcol, vcol, kfo = 0, ocol = 0, kt0, NT, wt_lo = 0, wt_hi, lut_sel = 0, myrow = 0;
    bf16_t* obuf = (bf16_t*)(p.ws + B_Y) + (size_t)MODE * S * 512;
    float m_run = NEGBIG, l_run = 0.f, lam = 0.f, lam_init = 0.f;
    if constexpr (MODE == 0) {
        const int h = ua, R0 = ub * 4; myrow = R0 + (wid >> 1); qtok0 = myrow * 64 + (wid & 1) * 32;
        qcol = h * 64; kcol = 512 + h * 64; vcol = h * 64; ocol = h * 64;
        const int rs_first = min(max(R0 - 4, 0), 248), rs_last = min(max(R0 + 3 - 4, 0), 248), my_rs = min(max(myrow - 4, 0), 248);
        kt0 = rs_first * 64; NT = rs_last + 8 - rs_first; wt_lo = my_rs - rs_first; wt_hi = wt_lo + 8;
        for (int i = tid; i < 15 * 127; i += 512) { const int dr_ = i / 127, dc_ = min(max(i % 127 - 48, 0), 30); lut[i] = p.na_rpb[(size_t)(l * 8 + h) * 465 + dr_ * 31 + dc_] * LOG2E; }
    } else if constexpr (MODE == 1) {
        const int h = ua, qb = ub, c = wid >> 2; qtok0 = qb * 128 + (wid & 3) * 32;
        qcol = 1536 + h * 128 + c * 64; kcol = 2048 + h * 128; kfo = c * 64; vcol = 512 + h * 128; ocol = h * 128;
        kt0 = 0; NT = S / 64; wt_hi = NT;
        for (int i = tid; i < 449; i += 512) lut[i] = p.rel_bias[t5_bucket(i - 224) * 12 + h] * LOG2E;
        const float* lq = p.diff_lambda + (size_t)l * 256;
        const float s1 = wave_sum(lq[lane] * lq[64 + lane]), s2 = wave_sum(lq[128 + lane] * lq[192 + lane]);
        lam_init = 0.8f - 0.6f * expf(-0.3f * (float)l);
        lam = expf(s1) - expf(s2) + lam_init;
    } else {
        const int g = ua, qb = ub, hq = g * 4 + (wid >> 1); qtok0 = qb * 64 + (wid & 1) * 32; lut_sel = wid >> 1;
        qcol = 3072 + hq * 64; kcol = 3584 + g * 64; vcol = 1024 + g * 64; ocol = hq * 64;
        const int tlo = max(qb - 2, 0), thi = min(qb + 2, S / 64 - 1); kt0 = tlo * 64; NT = thi - tlo + 1; wt_hi = NT;
        for (int i = tid; i < 4 * 449; i += 512) { const int hh = i / 449, rel = i % 449 - 224; lut[i] = (rel >= -128 && rel <= 128) ? p.rel_bias[t5_bucket(rel) * 12 + 4 + g * 4 + hh] * LOG2E : NEGBIG; }
        m_run = p.gqa_sink[l * 8 + hq] * LOG2E; l_run = (hi == 0) ? 1.0f : 0.0f;
    }
    bf16x8 qf[4];
    { const bf16_t* qp = proj + (size_t)(qtok0 + r32) * NPROJ + qcol + 8 * hi;
#pragma unroll
      for (int d0 = 0; d0 < 4; ++d0) qf[d0] = *(const bf16x8*)(qp + 16 * d0); }
    f32x16 o[NB];
#pragma unroll
    for (int nb = 0; nb < NB; ++nb)
#pragma unroll
        for (int r = 0; r < 16; ++r) o[nb][r] = 0.f;

    u32x4 kr[NKC], vr[NVC];
    unsigned ksrc[NKC], vsrc[NVC]; int kdst[NKC], vdst[NVC];
    const bf16_t* kvbase = proj + (size_t)kt0 * NPROJ;
#pragma unroll
    for (int i = 0; i < NKC; ++i) { const int cid = tid + 512 * i, row = cid / KCH, ch = cid % KCH; ksrc[i] = (unsigned)(row * NPROJ + kcol + ch * 8); kdst[i] = OFF_K + row * KPB + ch * 16; }
#pragma unroll
    for (int i = 0; i < NVC; ++i) { const int cid = tid + 512 * i, row = cid >> 3, ch = cid & 7; vsrc[i] = (unsigned)((vcol + row) * S + ch * 8); vdst[i] = OFF_V + row * VTP + (ch >> 1) * 32 + (ch & 1) * 8; }
    const bf16_t* vtbase = vtg + kt0;
    {
        u32x4 k1[NKC];
#pragma unroll
        for (int i = 0; i < NKC; ++i) { kr[i] = *(const u32x4*)(kvbase + ksrc[i]); k1[i] = *(const u32x4*)(kvbase + (size_t)64 * NPROJ + ksrc[i]); }
#pragma unroll
        for (int i = 0; i < NVC; ++i) vr[i] = *(const u32x4*)(vtbase + vsrc[i]);
#pragma unroll
        for (int i = 0; i < NKC; ++i) { *(LAS u32x4*)(lds + kdst[i]) = kr[i]; *(LAS u32x4*)(lds + kdst[i] + KBUF) = k1[i]; }
#pragma unroll
        for (int i = 0; i < NVC; ++i) { *(LAS u32x2*)(lds + vdst[i]) = (u32x2){vr[i].x, vr[i].y}; *(LAS u32x2*)(lds + vdst[i] + 16) = (u32x2){vr[i].z, vr[i].w}; }
#pragma unroll
        for (int i = 0; i < NKC; ++i) kr[i] = *(const u32x4*)(kvbase + (size_t)2 * 64 * NPROJ + ksrc[i]);
#pragma unroll
        for (int i = 0; i < NVC; ++i) vr[i] = *(const u32x4*)(vtbase + 64 + vsrc[i]);
    }
    __syncthreads();

    const int qpos = qtok0 + r32;
    const int i16 = lane & 15, q4 = i16 >> 2, p4 = i16 & 3, blk = (lane >> 4) & 1;
    const int vlane_off = r32 * VTP + hi * 16;
    const int klane_off = r32 * KPB + (kfo + 8 * hi) * 2;

    f32x16 sB0, sB1; float cbB = 0.f; bool fastB = false;
#define ATT_QK(tt) do { const LAS unsigned char* Kb_ = lds + OFF_K + ((tt) & 1) * KBUF + klane_off; \
        f32x16 z0_, z1_; _Pragma("unroll") for (int r = 0; r < 16; ++r) { z0_[r] = 0.f; z1_[r] = 0.f; } \
        _Pragma("unroll") for (int d0 = 0; d0 < 4; ++d0) { \
            const bf16x8 k0_ = *(const LAS bf16x8*)(Kb_ + d0 * 32), k1_ = *(const LAS bf16x8*)(Kb_ + 32 * KPB + d0 * 32); \
            z0_ = __builtin_amdgcn_mfma_f32_32x32x16_bf16(k0_, qf[d0], z0_, 0, 0, 0); z1_ = __builtin_amdgcn_mfma_f32_32x32x16_bf16(k1_, qf[d0], z1_, 0, 0, 0); } \
        sB0 = z0_; sB1 = z1_; } while (0)
#define ATT_MAX3(dst) do { float tm_ = max3f(sB0[0], sB1[0], sB0[1]), tn_ = max3f(sB1[1], sB0[2], sB1[2]); \
        _Pragma("unroll") for (int r = 3; r < 15; r += 2) { tm_ = max3f(tm_, sB0[r], sB1[r]); tn_ = max3f(tn_, sB0[r + 1], sB1[r + 1]); } \
        tm_ = max3f(tm_, sB0[15], sB1[15]); dst = max3f(tm_, tn_, tn_); } while (0)
#define ATT_BIAS(tt, tmraw) do { const int ktok_ = kt0 + 64 * (tt); bool fast_ = false; cbB = 0.f; const float nm_ = FROZEN ? -m_run : 0.f; \
        if constexpr (MODE == 1) { if (ktok_ - (qtok0 + 31) >= 128) { cbB = cb_pos; fast_ = true; } else if (qtok0 - (ktok_ + 63) >= 128) { cbB = cb_neg; fast_ = true; } } \
        if (!fast_) { \
            if constexpr (MODE != 0) { \
                const LAS float* lp_ = lut + (ktok_ - qpos + 224 + 4 * hi + (MODE == 2 ? lut_sel * 449 : 0)); \
                _Pragma("unroll") for (int r = 0; r < 16; ++r) { const int cr_ = (r & 3) + 8 * (r >> 2); sB0[r] += lp_[cr_] + nm_; if ((r & 7) == 7) __builtin_amdgcn_sched_barrier(0); } \
                _Pragma("unroll") for (int r = 0; r < 16; ++r) { const int cr_ = (r & 3) + 8 * (r >> 2); sB1[r] += lp_[cr_ + 32] + nm_; if ((r & 7) == 7) __builtin_amdgcn_sched_barrier(0); } \
            } else { \
                if (!((tt) >= wt_lo && (tt) < wt_hi)) { _Pragma("unroll") for (int r = 0; r < 16; ++r) { sB0[r] = -INFINITY; sB1[r] = -INFINITY; } } \
                else { \
                    const int qc = (wid & 1) * 32 + r32, cs = min(max(qc - 8, 0), 48), dr = min(max((kt0 >> 6) + (tt) - myrow + 7, 0), 14); \
                    const LAS float* lp_ = lut + (dr * 127 + 63 - qc + 4 * hi); const int kb_ = 4 * hi - cs; \
                    _Pragma("unroll") for (int r = 0; r < 16; ++r) { const int cr_ = (r & 3) + 8 * (r >> 2); \
                        sB0[r] = ((unsigned)(kb_ + cr_) < 16u) ? sB0[r] + lp_[cr_] : NEGBIG; sB1[r] = ((unsigned)(kb_ + cr_ + 32) < 16u) ? sB1[r] + lp_[cr_ + 32] : NEGBIG; if ((r & 3) == 3) __builtin_amdgcn_sched_barrier(0); } \
                } } if constexpr (!FROZEN) ATT_MAX3(tmraw); } \
        fastB = fast_; \
    } while (0)
#define ATT_UPD(tmraw) do { \
        if constexpr (FROZEN) {              \
            if (fastB && __any(cbB != m_run)) { \
                const float f_ = fast_exp2(m_run - cbB); l_run *= f_; m_run = cbB; \
                _Pragma("unroll") for (int nb = 0; nb < NB; ++nb) _Pragma("unroll") for (int r = 0; r < 16; ++r) o[nb][r] *= f_; } \
        } else { \
            const float tm_ = xhalf_max(tmraw) + cbB; \
            if (__any(tm_ > m_run)) { \
                const float mn_ = fmaxf(m_run, tm_), f_ = fast_exp2(m_run - mn_); l_run *= f_; m_run = mn_; \
                _Pragma("unroll") for (int nb = 0; nb < NB; ++nb) _Pragma("unroll") for (int r = 0; r < 16; ++r) o[nb][r] *= f_; } } \
    } while (0)

    float cb_pos = 0.f, cb_neg = 0.f;
    if constexpr (MODE == 1) { cb_pos = lut[448]; cb_neg = lut[0]; }
    ATT_QK(0);
    if constexpr (FROZEN) m_run = cb_neg;
    { float tm0 = 0.f; if constexpr (!FROZEN) ATT_MAX3(tm0); ATT_BIAS(0, tm0); ATT_UPD(tm0); }
    __syncthreads();

    for (int t = 0; t < NT; ++t) {
        if (t + 2 < NT) {
#pragma unroll
            for (int i = 0; i < NKC; ++i) *(LAS u32x4*)(lds + kdst[i] + (t & 1) * KBUF) = kr[i];
        }
        if (t + 1 < NT) {
#pragma unroll
            for (int i = 0; i < NVC; ++i) { *(LAS u32x2*)(lds + vdst[i] + ((t + 1) & 1) * VBUF) = (u32x2){vr[i].x, vr[i].y}; *(LAS u32x2*)(lds + vdst[i] + ((t + 1) & 1) * VBUF + 16) = (u32x2){vr[i].z, vr[i].w}; }
        }
        {
            const size_t advk = (size_t)min(t + 3, NT - 1) * 64 * NPROJ, advv = (size_t)min(t + 2, NT - 1) * 64;
#pragma unroll
            for (int i = 0; i < NKC; ++i) kr[i] = *(const u32x4*)(kvbase + advk + ksrc[i]);
#pragma unroll
            for (int i = 0; i < NVC; ++i) vr[i] = *(const u32x4*)(vtbase + advv + vsrc[i]);
        }
        f32x16 sA0 = sB0, sA1 = sB1;
        const float c2 = cbB - m_run;
        const LAS unsigned char* Vb = lds + OFF_V + (t & 1) * VBUF + vlane_off;
        const LAS unsigned char* Kb = lds + OFF_K + ((t + 1) & 1) * KBUF + klane_off;
#define SA_(ks, j) ((((ks) >> 1) == 0) ? sA0[8 * ((ks) & 1) + (j)] : sA1[8 * ((ks) & 1) + (j)])
#define EXPCVT(ks, PF, PSUM) do { float x_[8]; _Pragma("unroll") for (int j = 0; j < 8; ++j) x_[j] = FROZEN ? fast_exp2(SA_(ks, j)) : fast_exp2(SA_(ks, j) + c2); \
        PSUM = ((x_[0] + x_[1]) + (x_[2] + x_[3])) + ((x_[4] + x_[5]) + (x_[6] + x_[7])); \
        u32x4 pw_; pw_.x = pk2(x_[0], x_[1]); pw_.y = pk2(x_[2], x_[3]); pw_.z = pk2(x_[4], x_[5]); pw_.w = pk2(x_[6], x_[7]); PF = __builtin_bit_cast(bf16x8, pw_); } while (0)
#define VLOAD(ks, DST) do { const LAS unsigned char* vp_ = Vb + (ks) * 32; \
        _Pragma("unroll") for (int nb = 0; nb < NB; ++nb) DST[nb] = *(const LAS bf16x8*)(vp_ + nb * 32 * VTP); } while (0)
#define PVMMA(SRC, PF) do { _Pragma("unroll") for (int nb = 0; nb < NB; ++nb) o[nb] = __builtin_amdgcn_mfma_f32_32x32x16_bf16(SRC[nb], PF, o[nb], 0, 0, 0); } while (0)
#define SBAR_() __builtin_amdgcn_sched_barrier(0)
        bf16x8 kf0[4], kf1[4], va[NB], vb[NB], pf0, pf1; float ps0, ps1, ps2, ps3;
        VLOAD(0, va);
        EXPCVT(0, pf0, ps0);
        SBAR_();
        VLOAD(1, vb); PVMMA(va, pf0); EXPCVT(1, pf1, ps1); _Pragma("unroll") for (int g_ = 0; g_ < NB; ++g_) { __builtin_amdgcn_sched_group_barrier(0x008, 1, 0); __builtin_amdgcn_sched_group_barrier(0x100, 1, 0); __builtin_amdgcn_sched_group_barrier(0x400, 8 / NB, 0); __builtin_amdgcn_sched_group_barrier(0x002, 12 / NB, 0); } SBAR_();
        VLOAD(2, va);
#pragma unroll
        for (int d0 = 0; d0 < 4; ++d0) { kf0[d0] = *(const LAS bf16x8*)(Kb + d0 * 32); kf1[d0] = *(const LAS bf16x8*)(Kb + 32 * KPB + d0 * 32); }
        PVMMA(vb, pf1); EXPCVT(2, pf0, ps2); _Pragma("unroll") for (int g_ = 0; g_ < NB; ++g_) { __builtin_amdgcn_sched_group_barrier(0x008, 1, 0); __builtin_amdgcn_sched_group_barrier(0x100, 1, 0); __builtin_amdgcn_sched_group_barrier(0x400, 8 / NB, 0); __builtin_amdgcn_sched_group_barrier(0x002, 12 / NB, 0); } SBAR_();
        {
            f32x16 z0, z1;
#pragma unroll
            for (int r = 0; r < 16; ++r) { z0[r] = 0.f; z1[r] = 0.f; }
#pragma unroll
            for (int d0 = 0; d0 < 4; ++d0) { z0 = __builtin_amdgcn_mfma_f32_32x32x16_bf16(kf0[d0], qf[d0], z0, 0, 0, 0); z1 = __builtin_amdgcn_mfma_f32_32x32x16_bf16(kf1[d0], qf[d0], z1, 0, 0, 0); }
            sB0 = z0; sB1 = z1;
        }
        EXPCVT(3, pf1, ps3);
#pragma unroll
        for (int g_ = 0; g_ < 8; ++g_) { __builtin_amdgcn_sched_group_barrier(0x008, 1, 0); __builtin_amdgcn_sched_group_barrier(0x400, 1, 0); __builtin_amdgcn_sched_group_barrier(0x002, 2, 0); }
        SBAR_();
        float tmr;
        VLOAD(3, vb); SBAR_();
        PVMMA(va, pf0); if constexpr (!FROZEN) ATT_MAX3(tmr); else tmr = 0.f; PVMMA(vb, pf1);
        const float ps = (ps0 + ps1) + (ps2 + ps3);
#undef SA_
#undef EXPCVT
#undef VLOAD
#undef PVMMA
#undef SBAR_
        l_run += ps;
        if (t + 1 < NT) { ATT_BIAS(t + 1, tmr); ATT_UPD(tmr); }
        asm volatile("s_waitcnt lgkmcnt(0)" ::: "memory"); __builtin_amdgcn_s_barrier(); asm volatile("" ::: "memory");
    }
    __syncthreads();
#undef ATT_QK
#undef ATT_BIAS
#undef ATT_UPD
#undef ATT_MAX3
    if constexpr (FROZEN) {
        const float lt_ = xhalf_sum(l_run); const bool bad_ = !(lt_ > 0x1p-60f && lt_ < 0x1p60f);
        LAS unsigned* flg_ = (LAS unsigned*)(lds + OFF_LUT + 4096);
        if (tid == 0) *flg_ = 0u;
        __syncthreads();
        if (__any(bad_) && lane == 0) *flg_ = 1u;
        __syncthreads();
        const bool redo_ = (*flg_ != 0u);
        __syncthreads();
        if (redo_) return false;
    }
    const float linv = 1.0f / xhalf_sum(l_run);
#pragma unroll
    for (int nb = 0; nb < NB; ++nb)
#pragma unroll
        for (int r = 0; r < 16; ++r) o[nb][r] *= linv;
    if constexpr (MODE == 1) {
        LAS float* ex = (LAS float*)lds;
        if (wid >= 4) {
#pragma unroll
            for (int nb = 0; nb < NB; ++nb)
#pragma unroll
                for (int r = 0; r < 16; ++r) ex[((wid - 4) * 64 + nb * 16 + r) * 64 + lane] = o[nb][r];
        }
        __syncthreads();
        if (wid < 4) {
            float ss = 0.f;
#pragma unroll
            for (int nb = 0; nb < NB; ++nb)
#pragma unroll
                for (int r = 0; r < 16; ++r) { const float a = o[nb][r] - lam * ex[(wid * 64 + nb * 16 + r) * 64 + lane]; o[nb][r] = a; ss += a * a; }
            ss = xhalf_sum(ss);
            const float rinv = (1.0f - lam_init) / sqrtf(ss * (1.0f / 128.0f) + 1e-6f);
            const float* sg = p.diff_subln_g + (size_t)l * 128;
            bf16_t* op = obuf + (size_t)qpos * 512 + ocol;
#pragma unroll
            for (int nb = 0; nb < NB; ++nb)
#pragma unroll
                for (int rq = 0; rq < 4; ++rq) {
                    const int dv = 32 * nb + 8 * rq + 4 * hi; const f32x4 gg = *(const f32x4*)(sg + dv);
                    u32x2 w; w.x = pk2(o[nb][4 * rq] * rinv * gg.x, o[nb][4 * rq + 1] * rinv * gg.y); w.y = pk2(o[nb][4 * rq + 2] * rinv * gg.z, o[nb][4 * rq + 3] * rinv * gg.w);
                    *(u32x2*)(op + dv) = w;
                }
        }
        __syncthreads();
    } else {
        bf16_t* op = obuf + (size_t)qpos * 512 + ocol;
#pragma unroll
        for (int nb = 0; nb < NB; ++nb)
#pragma unroll
            for (int rq = 0; rq < 4; ++rq) {
                const int dv = 32 * nb + 8 * rq + 4 * hi;
                u32x2 w; w.x = pk2(o[nb][4 * rq], o[nb][4 * rq + 1]); w.y = pk2(o[nb][4 * rq + 2], o[nb][4 * rq + 3]);
                *(u32x2*)(op + dv) = w;
            }
    }
    return true;
}

__device__ __forceinline__ void attn_phase(LAS unsigned char* lds, const Params& p, int l) {
    unsigned redo_mask = 0u; int ui_ = 0;
    for (int u = blockIdx.x; u < 512; u += gridDim.x, ++ui_) { const int x = u & 7; if (!attn_unit<1, true>(lds, p, l, x >> 1, (x & 1) * 64 + (u >> 3))) redo_mask |= 1u << (ui_ & 31); }
    asm volatile("" : "+s"(redo_mask) :: "memory");
    if (redo_mask) {
        ui_ = 0;
        for (int u = blockIdx.x; u < 512; u += gridDim.x, ++ui_) { int x = u & 7, j = u >> 3; asm volatile("" : "+s"(x), "+s"(j)); if (redo_mask & (1u << (ui_ & 31))) (void)attn_unit<1, false>(lds, p, l, x >> 1, (x & 1) * 64 + j); }
    }
    for (int u = blockIdx.x; u < 512; u += gridDim.x) (void)attn_unit<0>(lds, p, l, u & 7, u >> 3);
    for (int u = blockIdx.x; u < 512; u += gridDim.x) (void)attn_unit<2>(lds, p, l, u & 1, u >> 1);
}

#define XB_TMO      128
#define XB_XCNT(j)  (256  + 64 * (j))
#define XB_XSUB(j)  (1280 + 64 * (j))
#define XB_XGEN(j)  (2304 + 64 * (j))
#define XB_TOP      3328
#define XB_TOPGEN   3392
#define XCD_BAR_WORDS 3456
#define XB_SPIN_CAP (1u << 18)

__device__ __forceinline__ unsigned xb_ld(unsigned* p)              { return __hip_atomic_load(p, __ATOMIC_RELAXED, __HIP_MEMORY_SCOPE_AGENT); }
__device__ __forceinline__ unsigned xb_add(unsigned* p, unsigned v) { return __hip_atomic_fetch_add(p, v, __ATOMIC_RELAXED, __HIP_MEMORY_SCOPE_AGENT); }
__device__ __forceinline__ unsigned xb_xcc_id() { return (unsigned)__builtin_amdgcn_s_getreg((3 << 11) | 20) & 0xFu; }
#define XB_SPIN(cond, bar) do { unsigned _sp = 0; while (cond) { __builtin_amdgcn_s_sleep(1); \
    if ((++_sp & 255u) == 0u) { if (xb_ld(&(bar)[XB_TMO])) break; if (_sp > XB_SPIN_CAP) { atomicAdd(&(bar)[XB_TMO], 1u); break; } } } } while (0)

struct XcdBarrier {
    unsigned* bar; unsigned x;
    volatile LAS unsigned* st;
};

__device__ __forceinline__ XcdBarrier xcd_barrier_post(unsigned* bar, volatile LAS unsigned* st) {
    XcdBarrier b; b.bar = bar; b.x = xb_xcc_id(); b.st = st;
    if (threadIdx.x == 0) (void)xb_add(&bar[XB_XCNT(b.x)], 1u);
    return b;
}
__device__ __forceinline__ void xcd_barrier_complete(unsigned* bar, unsigned x, unsigned& nloc, unsigned& nx) {
    const unsigned G = gridDim.x * gridDim.y * gridDim.z;
    unsigned sum, cnt, mine, sp = 0u;
    for (;;) {
        sum = 0u; cnt = 0u; mine = 0u;
#pragma unroll
        for (unsigned j = 0; j < 16; ++j) { const unsigned c = xb_ld(&bar[XB_XCNT(j)]); sum += c; cnt += (c > 0u) ? 1u : 0u; mine = (j == x) ? c : mine; }
        if (sum == G) break;
        __builtin_amdgcn_s_sleep(1);
        if ((++sp & 255u) == 0u) { if (xb_ld(&bar[XB_TMO])) break; if (sp > XB_SPIN_CAP) { atomicAdd(&bar[XB_TMO], 1u); break; } }
    }
    nloc = mine > 0u ? mine : 1u; nx = cnt > 0u ? cnt : 1u;
}

__device__ __forceinline__ void xcd_barrier(const XcdBarrier& b) {
    asm volatile("s_waitcnt vmcnt(0)" ::: "memory");
    __syncthreads();
    if (threadIdx.x == 0) {
        unsigned* bar = b.bar;
        __builtin_amdgcn_s_waitcnt(0);
        unsigned nloc = b.st[0], nx = b.st[1];
        if (nloc == 0u) { xcd_barrier_complete(bar, b.x, nloc, nx); b.st[0] = nloc; b.st[1] = nx; }
        const unsigned old = xb_add(&bar[XB_XSUB(b.x)], 1u);
        const unsigned gen = old / nloc;
        if (old + 1u == (gen + 1u) * nloc) {
            __builtin_amdgcn_fence(__ATOMIC_RELEASE, "agent");
            asm volatile("s_waitcnt vmcnt(0)" ::: "memory");
            const unsigned og = xb_add(&bar[XB_TOP], 1u);
            const unsigned tg = og / nx;
            if (og + 1u == (tg + 1u) * nx) xb_add(&bar[XB_TOPGEN], 1u);
            else XB_SPIN(xb_ld(&bar[XB_TOPGEN]) == tg, bar);
            __builtin_amdgcn_fence(__ATOMIC_ACQUIRE, "agent");
            xb_add(&bar[XB_XGEN(b.x)], 1u);
            asm volatile("s_waitcnt vmcnt(0)" ::: "memory");
        } else {
            XB_SPIN(xb_ld(&bar[XB_XGEN(b.x)]) == gen, bar);
            __builtin_amdgcn_fence(__ATOMIC_ACQUIRE, "agent");
            asm volatile("s_waitcnt vmcnt(0)" ::: "memory");
        }
    }
    __syncthreads();
}

__global__ void __launch_bounds__(512) mk_fwd(Params p) {
    extern __shared__ __attribute__((aligned(16))) unsigned char lds_raw[];
    LAS unsigned char* lds = (LAS unsigned char*)lds_raw;
    cg::grid_group grid = cg::this_grid();
    volatile LAS unsigned* bst = (volatile LAS unsigned*)(lds + 131072);
    if (threadIdx.x < 4) bst[threadIdx.x] = 0u;
    __syncthreads();
    const XcdBarrier bar = xcd_barrier_post((unsigned*)(p.ws + B_BAR), bst);
    bf16_t* XB = (bf16_t*)(p.ws + B_XB); bf16_t* PROJ = (bf16_t*)(p.ws + B_PROJ); bf16_t* G = (bf16_t*)(p.ws + B_G); bf16_t* Y = (bf16_t*)(p.ws + B_Y); bf16_t* MRG = (bf16_t*)(p.ws + B_MRG);
    float* SSQ = (float*)(p.ws + B_SSQ);
    bf16_t* HID = G;
    for (int step = p.step_lo; step < p.step_hi; ++step) {
        if (step == 0) {
            convert_layer(p, 0, lds, 0, CV_NITEMS, (int)blockIdx.x, (int)gridDim.x);
            prologue_rows(p.x, XB, SSQ);
        } else if (step == NSTEPS - 1) {
            final_norm(p.out, p.final_g);
        } else {
            const int l = (step - 1) / NSTEP_PER_LAYER, s = (step - 1) - l * NSTEP_PER_LAYER;
            bf16_t* W = (bf16_t*)(p.ws + B_W) + (size_t)(l & 1) * E_WTOT;
            if (s == 0 || s == 6) {
                pg8::Gemm g{XB, W + (s == 6 ? O_WGU1 : O_WGU0), S, 2 * DFF, DM}; pg8::StaticOrder So; So.init(S, 2 * DFF, gridDim.x, blockIdx.x);
                EpiSwiGLU E{HID, SSQ + (size_t)(l * 3 + (s == 6 ? 2 : 0)) * S * 16};
                pg8::gemm_phase<EpiSwiGLU, pg8::StaticOrder, true, true>(lds, g, So, E);
                {
                    const int full = (S / 256) * (2 * DFF / 256) % (int)gridDim.x;
                    if (l + 1 < NDEPTH && full != 0 && (int)blockIdx.x >= full)
                        convert_layer(p, l + 1, lds, s == 0 ? 0 : CV_CUT1, s == 0 ? CV_CUT1 : CV_CUT2, (int)blockIdx.x - full, (int)gridDim.x - full);
                    else if (l + 1 < NDEPTH && full == 0 && s == 6) convert_layer(p, l + 1, lds, 0, CV_CUT2, (int)blockIdx.x, (int)gridDim.x);
                }
            } else if (s == 1 || s == 7 || s == 5) {
                const bool ffn = (s != 5);
                pg8::Gemm g{ffn ? HID : MRG, W + (s == 1 ? O_WD0 : (s == 7 ? O_WD1 : O_WO)), S, DM, ffn ? DFF : DM}; pg8::StaticOrder So; So.init(S, DM, gridDim.x, blockIdx.x);
                const int nj = (s == 1) ? l * 3 + 1 : ((s == 5) ? l * 3 + 2 : l * 3 + 3);
                EpiResid E{(l == 0 && s == 1) ? p.x : p.out, p.out, XB, (nj < 12) ? SSQ + (size_t)nj * S * 16 : nullptr, ffn ? 0.5f : 1.0f};
                pg8::gemm_phase<EpiResid, pg8::StaticOrder, true, true>(lds, g, So, E);
            } else if (s == 2) {
                pg8::Gemm g{XB, W + O_WING, S, NPROJ + NGATE, DM}; pg8::StaticOrder So; So.init(S, NPROJ + NGATE, gridDim.x, blockIdx.x);
                EpiProjGate E{PROJ, G, p.b_gate + (size_t)l * NGATE, SSQ + (size_t)(l * 3 + 1) * S * 16, (bf16_t*)(p.ws + B_VT)};
                pg8::gemm_phase<EpiProjGate, pg8::StaticOrder, true, true>(lds, g, So, E);
                {
                    const int full = (S / 256) * ((NPROJ + NGATE) / 256) % (int)gridDim.x;
                    if (l + 1 < NDEPTH && full != 0 && (int)blockIdx.x >= full) convert_layer(p, l + 1, lds, CV_CUT2, CV_NITEMS, (int)blockIdx.x - full, (int)gridDim.x - full);
                    else if (l + 1 < NDEPTH && full == 0) convert_layer(p, l + 1, lds, CV_CUT2, CV_NITEMS, (int)blockIdx.x, (int)gridDim.x);
                }
            } else if (s == 3) {
                attn_phase(lds, p, l);
            } else if (s == 4) {
                for (int i = 0; i < 3; ++i) {
                    pg8::Gemm g{Y + (size_t)i * S * 512, W + O_WB + (size_t)i * E_WB, S, DM, 512}; pg8::StaticOrder So; So.init(S, DM, gridDim.x, blockIdx.x);
                    EpiBranch E{G, MRG, i * DM, i == 0};
                    pg8::gemm_phase<EpiBranch, pg8::StaticOrder, true, true>(lds, g, So, E);
                }
            }
        }
        if (step + 1 < p.step_hi) { if (step == p.step_lo) grid.sync(); else xcd_barrier(bar); }
    }
}

extern "C" void kernel_launch(void* const* d_in, const int* in_sizes, int n_in, void* d_out, int out_size, void* d_ws, size_t ws_size, hipStream_t stream) {
    static int grid = 0;
    if (grid == 0) {
        if (n_in != 16 || ws_size < B_END) { fprintf(stderr, "kernel_launch: unexpected n_in %d or ws_size %zu (< %zu)\n", n_in, ws_size, (size_t)B_END); grid = -1; return; }
        int dev = 0, cus = 0, per_cu = 0;
        hipGetDevice(&dev); hipDeviceGetAttribute(&cus, hipDeviceAttributeMultiprocessorCount, dev);
        if (hipFuncSetAttribute((const void*)mk_fwd, hipFuncAttributeMaxDynamicSharedMemorySize, LDS_BYTES) != hipSuccess) { fprintf(stderr, "kernel_launch: hipFuncSetAttribute failed\n"); grid = -1; return; }
        hipOccupancyMaxActiveBlocksPerMultiprocessor(&per_cu, (const void*)mk_fwd, 512, LDS_BYTES);
        if (per_cu < 1) { fprintf(stderr, "kernel_launch: occupancy query says %d blocks per CU\n", per_cu); per_cu = 1; }
        (void)hipGetLastError();
        grid = cus;
    }
    if (grid < 0) return;
    Params p{};
    p.x = (const float*)d_in[0]; p.w_in = (const float*)d_in[1]; p.w_branch = (const float*)d_in[2]; p.w_gate = (const float*)d_in[3]; p.b_gate = (const float*)d_in[4];
    p.w_o = (const float*)d_in[5]; p.norm_g = (const float*)d_in[6]; p.final_g = (const float*)d_in[7]; p.ffn_w_gate = (const float*)d_in[8]; p.ffn_w_up = (const float*)d_in[9];
    p.ffn_w_down = (const float*)d_in[10]; p.na_rpb = (const float*)d_in[11]; p.diff_lambda = (const float*)d_in[12]; p.diff_subln_g = (const float*)d_in[13]; p.gqa_sink = (const float*)d_in[14];
    p.rel_bias = (const float*)d_in[15]; p.out = (float*)d_out; p.ws = (unsigned char*)d_ws; p.step_lo = 0; p.step_hi = NSTEPS;
    if (hipMemsetAsync((char*)d_ws + B_BAR, 0, 16384, stream) != hipSuccess) { fprintf(stderr, "kernel_launch: hipMemsetAsync failed\n"); return; }
    void* args[] = {&p};
    hipError_t e = hipLaunchCooperativeKernel((const void*)mk_fwd, dim3(grid), dim3(512), args, LDS_BYTES, stream);
    if (e != hipSuccess) fprintf(stderr, "kernel_launch: cooperative launch failed: %s (grid %d)\n", hipGetErrorString(e), grid);
}
```
